# Optimizing an MI355X kernel written in HIP

```python
import math
import jax, jax.numpy as jnp
from jax import lax
import numpy as np

D_MODEL = 1024
BATCH = 4
SEQ = 8192
DEPTH = 2

HEAD_DIM = 64
Q_BLOCK = 128
A_HEADS = 4
A_QK = A_HEADS * 2 * HEAD_DIM
A_V = A_HEADS * 2 * HEAD_DIM
B_HEADS = 8
B_W = B_HEADS * HEAD_DIM
GRID_W = 64
NA_ROWS_MAX = 8
NA_COLS = 16
C_HEADS = 8
C_W = C_HEADS * HEAD_DIM
C_CONFIGS = ((128, 1), (512, 4), (2048, 16))
T5_BUCKETS = 32
T5_MAX_DIST = 1024
T5_HEADS = A_HEADS + C_HEADS
D_FF = 2816
N_BRANCH = 3
IN_SPLITS = [A_QK, A_QK, A_V, B_W, B_W, B_W, C_W, C_W, C_W]
IN_COLS = sum(IN_SPLITS) + N_BRANCH * D_MODEL
EPS = 1e-6

kernel_name = "hybrid_gated_diff_na_dilated_encoder"


def rmsnorm(x, g):
    xf = x.astype(jnp.float32)
    y = xf * lax.rsqrt(jnp.mean(xf * xf, axis=-1, keepdims=True) + EPS)
    return (y * g.astype(jnp.float32)).astype(x.dtype)


def swiglu(h, w1, w3, w2):
    return (jax.nn.silu(h @ w1) * (h @ w3)) @ w2


def t5_bucket(rel):
    nb = T5_BUCKETS // 2
    max_exact = nb // 2
    ret = jnp.where(rel > 0, nb, 0)
    n = jnp.abs(rel)
    nf = jnp.maximum(n, 1).astype(jnp.float32)
    large = max_exact + (jnp.log(nf / max_exact) / math.log(T5_MAX_DIST / max_exact)
                         * (nb - max_exact)).astype(jnp.int32)
    large = jnp.minimum(large, nb - 1)
    return ret + jnp.where(n < max_exact, n, large)


def diff_attention(q, k, v, bias_table, lam_full, subln_g, lam_init):
    B, S = q.shape[0], q.shape[1]
    nblk = S // Q_BLOCK
    scale = HEAD_DIM ** -0.5
    qb = (q * scale).reshape(B, nblk, Q_BLOCK, A_HEADS, 2, HEAD_DIM).transpose(1, 0, 3, 4, 2, 5)
    kt = k.transpose(0, 2, 3, 1, 4)
    vt = v.transpose(0, 2, 1, 3)
    kpos = jnp.arange(S)

    def block(args):
        qblk, i = args
        qpos = i * Q_BLOCK + jnp.arange(Q_BLOCK)
        bias = bias_table[t5_bucket(kpos[None, :] - qpos[:, None])].astype(jnp.float32)
        s = jnp.einsum('bhmqd,bhmkd->bhmqk', qblk, kt).astype(jnp.float32)
        s = s + bias.transpose(2, 0, 1)[None, :, None]
        pr = jax.nn.softmax(s, axis=-1)
        attn = pr[:, :, 0] - lam_full.astype(jnp.float32) * pr[:, :, 1]
        return jnp.einsum('bhqk,bhke->bhqe', attn.astype(v.dtype), vt)

    o = lax.map(block, (qb, jnp.arange(nblk)))
    o = o.transpose(1, 0, 3, 2, 4).reshape(B, S, A_HEADS, 2 * HEAD_DIM)
    o = rmsnorm(o, subln_g) * (1.0 - lam_init)
    return o.reshape(B, S, A_V)


def neighborhood_attention(q, k, v, rpb):
    B, S = q.shape[0], q.shape[1]
    rows = S // GRID_W
    kh = min(NA_ROWS_MAX, rows)
    kw = min(NA_COLS, GRID_W)
    scale = HEAD_DIM ** -0.5
    grid = lambda t: t.reshape(B, rows, GRID_W, B_HEADS, HEAD_DIM)
    qg = (grid(q) * scale).transpose(1, 0, 3, 2, 4)
    kg = grid(k).transpose(0, 3, 1, 2, 4)
    vg = grid(v).transpose(0, 3, 1, 2, 4)
    col = jnp.arange(GRID_W)
    cstart = jnp.clip(col - kw // 2, 0, GRID_W - kw)
    cidx = cstart[:, None] + jnp.arange(kw)[None, :]
    rel_c = cidx - col[:, None] + (NA_COLS - 1)

    def row_block(args):
        qrow, i = args
        rstart = jnp.clip(i - kh // 2, 0, rows - kh)
        krow = lax.dynamic_slice_in_dim(kg, rstart, kh, axis=2)
        vrow = lax.dynamic_slice_in_dim(vg, rstart, kh, axis=2)
        knb = krow[:, :, :, cidx]
        vnb = vrow[:, :, :, cidx]
        rel_r = rstart + jnp.arange(kh) - i + (NA_ROWS_MAX - 1)
        bias = rpb[:, rel_r[:, None, None], rel_c[None]].astype(jnp.float32)
        s = jnp.einsum('bhqd,bhrqcd->bhqrc', qrow, knb).astype(jnp.float32)
        s = s + bias.transpose(0, 2, 1, 3)[None]
        pr = jax.nn.softmax(s.reshape(B, B_HEADS, GRID_W, kh * kw), axis=-1)
        pr = pr.reshape(B, B_HEADS, GRID_W, kh, kw)
        return jnp.einsum('bhqrc,bhrqcd->bhqd', pr.astype(v.dtype), vnb)

    o = lax.map(row_block, (qg, jnp.arange(rows)))
    return o.transpose(1, 0, 3, 2, 4).reshape(B, S, B_W)


def dilated_attention(q, k, v, bias_table):
    B, S = q.shape[0], q.shape[1]
    nblk = S // Q_BLOCK
    scale = HEAD_DIM ** -0.5
    qb = (q * scale).reshape(B, nblk, Q_BLOCK, C_HEADS, HEAD_DIM).transpose(1, 0, 3, 2, 4)
    kt = k.transpose(0, 2, 1, 3)
    vt = v.transpose(0, 2, 1, 3)
    cfgs = [(w // (2 * r), r) for (w, r) in C_CONFIGS]
    max_pad = max(hf * r for (hf, r) in cfgs)
    kp = jnp.pad(kt, ((0, 0), (0, 0), (max_pad, max_pad), (0, 0)))
    vp = jnp.pad(vt, ((0, 0), (0, 0), (max_pad, max_pad), (0, 0)))

    def block(args):
        qblk, i = args
        qpos = i * Q_BLOCK + jnp.arange(Q_BLOCK)
        outs, lses = [], []
        for half, r in cfgs:
            offs = r * jnp.arange(-half, half + 1)
            kpos = qpos[:, None] + offs[None, :]
            valid = (kpos >= 0) & (kpos < S)
            kgat = kp[:, :, kpos + max_pad]
            vgat = vp[:, :, kpos + max_pad]
            bias = bias_table[t5_bucket(offs)].astype(jnp.float32)
            s = jnp.einsum('bhqd,bhqjd->bhqj', qblk, kgat).astype(jnp.float32)
            s = jnp.where(valid[None, None], s + bias.T[None, :, None, :], -jnp.inf)
            m = jnp.max(s, axis=-1, keepdims=True)
            e = jnp.exp(s - m)
            den = jnp.sum(e, axis=-1, keepdims=True)
            outs.append(jnp.einsum('bhqj,bhqjd->bhqd', (e / den).astype(v.dtype), vgat))
            lses.append(m + jnp.log(den))
        wts = jax.nn.softmax(jnp.concatenate(lses, axis=-1), axis=-1)
        return jnp.einsum('bhqn,nbhqd->bhqd', wts.astype(v.dtype), jnp.stack(outs))

    o = lax.map(block, (qb, jnp.arange(nblk)))
    return o.transpose(1, 0, 3, 2, 4).reshape(B, S, C_W)


def setup_inputs(seed: int = 0) -> dict:
    key = jax.random.key(seed)
    ks = jax.random.split(key, 26)
    nrm = lambda k, shape, s: jax.random.normal(k, shape, jnp.float32) * s
    gain = lambda k, shape: 1.0 + 0.05 * jax.random.normal(k, shape, jnp.float32)
    D = D_MODEL
    return {
        "x": nrm(ks[0], (BATCH, SEQ, D), 1.0),
        "g_ff1": gain(ks[1], (DEPTH, D)),
        "w1_ff1": nrm(ks[2], (DEPTH, D, D_FF), D ** -0.5),
        "w3_ff1": nrm(ks[3], (DEPTH, D, D_FF), D ** -0.5),
        "w2_ff1": nrm(ks[4], (DEPTH, D_FF, D), D_FF ** -0.5),
        "g_mix": gain(ks[5], (DEPTH, D)),
        "w_in": nrm(ks[6], (DEPTH, D, IN_COLS), D ** -0.5),
        "lam_q1": nrm(ks[7], (DEPTH, HEAD_DIM), 0.1),
        "lam_k1": nrm(ks[8], (DEPTH, HEAD_DIM), 0.1),
        "lam_q2": nrm(ks[9], (DEPTH, HEAD_DIM), 0.1),
        "lam_k2": nrm(ks[10], (DEPTH, HEAD_DIM), 0.1),
        "subln_g": gain(ks[11], (DEPTH, 2 * HEAD_DIM)),
        "na_rpb": nrm(ks[12], (DEPTH, B_HEADS, 2 * NA_ROWS_MAX - 1, 2 * NA_COLS - 1), 0.5),
        "t5_table": nrm(ks[13], (T5_BUCKETS, T5_HEADS), 0.5),
        "w_br_a": nrm(ks[14], (DEPTH, A_V, D), A_V ** -0.5),
        "w_br_b": nrm(ks[15], (DEPTH, B_W, D), B_W ** -0.5),
        "w_br_c": nrm(ks[16], (DEPTH, C_W, D), C_W ** -0.5),
        "w_o": nrm(ks[17], (DEPTH, D, D), D ** -0.5),
        "g_ff2": gain(ks[18], (DEPTH, D)),
        "w1_ff2": nrm(ks[19], (DEPTH, D, D_FF), D ** -0.5),
        "w3_ff2": nrm(ks[20], (DEPTH, D, D_FF), D ** -0.5),
        "w2_ff2": nrm(ks[21], (DEPTH, D_FF, D), D_FF ** -0.5),
        "g_final": gain(ks[22], (D,)),
    }


def reference(x, g_ff1, w1_ff1, w3_ff1, w2_ff1, g_mix, w_in, lam_q1, lam_k1, lam_q2, lam_k2,
              subln_g, na_rpb, t5_table, w_br_a, w_br_b, w_br_c, w_o, g_ff2, w1_ff2, w3_ff2,
              w2_ff2, g_final):
    B, S, D = x.shape
    split_idx = [int(c) for c in np.cumsum(IN_SPLITS)]
    t5_a = t5_table[:, :A_HEADS]
    t5_c = t5_table[:, A_HEADS:]
    for l in range(DEPTH):
        x = x + 0.5 * swiglu(rmsnorm(x, g_ff1[l]), w1_ff1[l], w3_ff1[l], w2_ff1[l])
        h = rmsnorm(x, g_mix[l])
        p = h @ w_in[l]
        aq, ak, av, bq, bk, bv, cq, ck, cv, gates = jnp.split(p, split_idx, axis=-1)
        lam_init = 0.8 - 0.6 * math.exp(-0.3 * l)
        lam_full = (jnp.exp(jnp.sum(lam_q1[l] * lam_k1[l])) - jnp.exp(jnp.sum(lam_q2[l] * lam_k2[l]))
                    + lam_init)
        o_a = diff_attention(aq.reshape(B, S, A_HEADS, 2, HEAD_DIM),
                             ak.reshape(B, S, A_HEADS, 2, HEAD_DIM),
                             av.reshape(B, S, A_HEADS, 2 * HEAD_DIM),
                             t5_a, lam_full, subln_g[l], lam_init)
        hd = lambda t, nh: t.reshape(B, S, nh, HEAD_DIM)
        o_b = neighborhood_attention(hd(bq, B_HEADS), hd(bk, B_HEADS), hd(bv, B_HEADS), na_rpb[l])
        o_c = dilated_attention(hd(cq, C_HEADS), hd(ck, C_HEADS), hd(cv, C_HEADS), t5_c)
        g = jax.nn.sigmoid(gates.reshape(B, S, N_BRANCH, D))
        merged = (g[:, :, 0] * (o_a @ w_br_a[l]) + g[:, :, 1] * (o_b @ w_br_b[l])
                  + g[:, :, 2] * (o_c @ w_br_c[l]))
        x = x + merged @ w_o[l]
        x = x + 0.5 * swiglu(rmsnorm(x, g_ff2[l]), w1_ff2[l], w3_ff2[l], w2_ff2[l])
    return rmsnorm(x, g_final)
```

```cpp
#include <hip/hip_runtime.h>
#include <hip/hip_cooperative_groups.h>
#include <cstdio>
#include <cstdint>
#include <cmath>
namespace cg = cooperative_groups;
namespace pg8 {
#define PG8_LAS __attribute__((address_space(3)))
typedef unsigned short bf16_t;
typedef short bf16x8 __attribute__((ext_vector_type(8)));
typedef float f32x4 __attribute__((ext_vector_type(4)));
typedef unsigned u32x4 __attribute__((ext_vector_type(4)));
constexpr int BM = 256, BK = 64, HALF = 128, HTB = HALF * BK * 2  , STAGE_BYTES = 8 * HTB, NXCD = 8, WGM = 8;

__host__ __device__ __forceinline__ int lds_byte(int r, int c) { const int st = (r >> 4) * 2 + (c >> 5), rr = r & 15, cc = c & 31, ob = rr * 64 + cc * 2; return st * 1024 + (ob ^ (((ob >> 9) & 1) << 5)); }
__host__ __device__ __forceinline__ void stage_rc(int b, int& R, int& C) { const int st = b / 1024, sb = b % 1024, swz = sb ^ (((sb >> 9) & 1) << 5); R = (st >> 1) * 16 + swz / 64; C = (st & 1) * 32 + (swz % 64) / 2; }
__host__ __device__ __forceinline__ int perm32(int rho) { const int n = rho >> 4, i = rho & 15; return 8 * (i >> 2) + 4 * n + (i & 3); }

struct Unit { int pm, pn; };
struct Gemm { const bf16_t* A; const bf16_t* Bt; int M, N, K, lda, ldb; };

struct StaticOrder {
    int nM, nN, nwg, G, c;
    __host__ __device__ void init(int M, int N, int G_, int c_) { nM = M / BM; nN = N / BM; nwg = nM * nN; G = G_; c = c_; }
    __host__ __device__ bool next(int i, Unit& u) const {
        const long L = (long)i * G + c; if (L >= nwg) return false;
        int wgid = (int)L; { const int q = nwg / NXCD, r = nwg % NXCD, xcd = wgid % NXCD, off = wgid / NXCD; wgid = (xcd < r ? xcd * (q + 1) : r * (q + 1) + (xcd - r) * q) + off; }
        const int nig = WGM * nN, gid = wgid / nig, fm = gid * WGM, gsz = (nM - fm) < WGM ? (nM - fm) : WGM;
        u.pm = fm + ((wgid % nig) % gsz); u.pn = (wgid % nig) / gsz; return true;
    }
    __device__ __forceinline__ void a_ready(const Unit&) const {}
    __device__ __forceinline__ void done(const Unit&) const {}
};

typedef float f32x2_t __attribute__((ext_vector_type(2))); typedef __bf16 bf16x2_t __attribute__((ext_vector_type(2)));
__device__ __forceinline__ unsigned cvt_pk_bf16(float lo, float hi) { f32x2_t v = {lo, hi}; bf16x2_t b = __builtin_convertvector(v, bf16x2_t); return __builtin_bit_cast(unsigned, b); }
__device__ __forceinline__ float bf_lo(unsigned w) { return __builtin_bit_cast(float, w << 16); }
__device__ __forceinline__ float bf_hi(unsigned w) { return __builtin_bit_cast(float, w & 0xffff0000u); }
__device__ __forceinline__ float sigmoid_f(float v) { return __builtin_amdgcn_rcpf(1.0f + __builtin_amdgcn_exp2f(-1.4426950408889634f * v)); }

template <int ACT> struct EpiBf16 {
    static constexpr bool PERM = true, AFTER_DRAIN = false;
    bf16_t* O; int ldc; int split_cols; size_t split_stride; float scale0;
    __device__ __forceinline__ void operator()(const f32x4 (&acc)[2][2][4][2], const Unit& u, int wr, int wc, int fr, int fq) const {
        const int row0 = u.pm * BM + wr * 64 + fr; int colt = u.pn * BM; bf16_t* base = O;
        float sc = 1.f; if (split_cols) { const int t = colt / split_cols; base += (size_t)t * split_stride; colt -= t * split_cols; if (t == 0) sc = scale0; }
        const int col0 = colt + wc * 32 + 8 * fq;
#pragma unroll
        for (int ai = 0; ai < 2; ++ai)
#pragma unroll
            for (int m = 0; m < 4; ++m) { bf16_t* rowp = base + (size_t)(row0 + ai * HALF + m * 16) * ldc + col0;
#pragma unroll
                for (int bj = 0; bj < 2; ++bj) { f32x4 v0 = acc[ai][bj][m][0], v1 = acc[ai][bj][m][1];
                    if (ACT == 2) { v0 = (f32x4){sigmoid_f(v0[0]), sigmoid_f(v0[1]), sigmoid_f(v0[2]), sigmoid_f(v0[3])}; v1 = (f32x4){sigmoid_f(v1[0]), sigmoid_f(v1[1]), sigmoid_f(v1[2]), sigmoid_f(v1[3])}; }
                    v0 = v0 * sc; v1 = v1 * sc; u32x4 w; w.x = cvt_pk_bf16(v0[0], v0[1]); w.y = cvt_pk_bf16(v0[2], v0[3]); w.z = cvt_pk_bf16(v1[0], v1[1]); w.w = cvt_pk_bf16(v1[2], v1[3]);
                    *(u32x4*)(rowp + bj * HALF) = w; } asm volatile("" ::: "memory"); }
    }
};
struct EpiSwiGLU {
    static constexpr bool PERM = true, AFTER_DRAIN = false;
    bf16_t* U; int ldc;
    __device__ __forceinline__ void operator()(const f32x4 (&acc)[2][2][4][2], const Unit& u, int wr, int wc, int fr, int fq) const {
        const int row0 = u.pm * BM + wr * 64 + fr; const int col0 = u.pn * HALF + wc * 32 + 8 * fq;
#pragma unroll
        for (int ai = 0; ai < 2; ++ai)
#pragma unroll
            for (int m = 0; m < 4; ++m) { bf16_t* rowp = U + (size_t)(row0 + ai * HALF + m * 16) * ldc + col0;
                float r[8];
#pragma unroll
                for (int n = 0; n < 2; ++n)
#pragma unroll
                    for (int j = 0; j < 4; ++j) { const float a = acc[ai][0][m][n][j], b = acc[ai][1][m][n][j]; r[n * 4 + j] = a * sigmoid_f(a) * b; }
                u32x4 w; w.x = cvt_pk_bf16(r[0], r[1]); w.y = cvt_pk_bf16(r[2], r[3]); w.z = cvt_pk_bf16(r[4], r[5]); w.w = cvt_pk_bf16(r[6], r[7]);
                *(u32x4*)rowp = w; asm volatile("" ::: "memory"); }
    }
};
struct EpiResid {
    static constexpr bool PERM = false, AFTER_DRAIN = false;
    const float* xin; float* xout; int ldc; float s;
    __device__ __forceinline__ void operator()(const f32x4 (&acc)[2][2][4][2], const Unit& u, int wr, int wc, int fr, int fq) const {
        const int col0 = u.pn * BM + wc * 32 + 4 * fq;
#pragma unroll
        for (int ai = 0; ai < 2; ++ai) {
            f32x4 bs[4][2][2];
#pragma unroll
            for (int m = 0; m < 4; ++m) { const size_t off = (size_t)(u.pm * BM + ai * HALF + wr * 64 + m * 16 + fr) * ldc + col0;
#pragma unroll
                for (int bj = 0; bj < 2; ++bj)
#pragma unroll
                    for (int n = 0; n < 2; ++n) bs[m][bj][n] = *(const f32x4*)(xin + off + bj * HALF + n * 16); }
            asm volatile("" ::: "memory");
#pragma unroll
            for (int m = 0; m < 4; ++m) { const size_t off = (size_t)(u.pm * BM + ai * HALF + wr * 64 + m * 16 + fr) * ldc + col0;
#pragma unroll
                for (int bj = 0; bj < 2; ++bj)
#pragma unroll
                    for (int n = 0; n < 2; ++n) *(f32x4*)(xout + off + bj * HALF + n * 16) = bs[m][bj][n] + acc[ai][bj][m][n] * s; }
            asm volatile("" ::: "memory"); }
    }
};
struct EpiGate {
    static constexpr bool PERM = true, AFTER_DRAIN = false;
    const bf16_t* G; bf16_t* MG; int ldc; int first;
    __device__ __forceinline__ void operator()(const f32x4 (&acc)[2][2][4][2], const Unit& u, int wr, int wc, int fr, int fq) const {
        const int row0 = u.pm * BM + wr * 64 + fr; const int col0 = u.pn * BM + wc * 32 + 8 * fq;
#pragma unroll
        for (int ai = 0; ai < 2; ++ai) {
            u32x4 g[4][2], p[4][2];
#pragma unroll
            for (int m = 0; m < 4; ++m) { const size_t off = (size_t)(row0 + ai * HALF + m * 16) * ldc + col0;
#pragma unroll
                for (int bj = 0; bj < 2; ++bj) { g[m][bj] = *(const u32x4*)(G + off + bj * HALF); if (!first) p[m][bj] = *(const u32x4*)(MG + off + bj * HALF); else p[m][bj] = (u32x4){0u, 0u, 0u, 0u}; } }
            asm volatile("" ::: "memory");
#pragma unroll
            for (int m = 0; m < 4; ++m) { const size_t off = (size_t)(row0 + ai * HALF + m * 16) * ldc + col0;
#pragma unroll
                for (int bj = 0; bj < 2; ++bj) { const u32x4 gg = g[m][bj], pp = p[m][bj]; const f32x4 v0 = acc[ai][bj][m][0], v1 = acc[ai][bj][m][1];
                    u32x4 w;
                    w.x = cvt_pk_bf16(bf_lo(gg.x) * v0[0] + bf_lo(pp.x), bf_hi(gg.x) * v0[1] + bf_hi(pp.x)); w.y = cvt_pk_bf16(bf_lo(gg.y) * v0[2] + bf_lo(pp.y), bf_hi(gg.y) * v0[3] + bf_hi(pp.y));
                    w.z = cvt_pk_bf16(bf_lo(gg.z) * v1[0] + bf_lo(pp.z), bf_hi(gg.z) * v1[1] + bf_hi(pp.z)); w.w = cvt_pk_bf16(bf_lo(gg.w) * v1[2] + bf_lo(pp.w), bf_hi(gg.w) * v1[3] + bf_hi(pp.w));
                    *(u32x4*)(MG + off + bj * HALF) = w; } }
            asm volatile("" ::: "memory"); }
    }
};
template <class Epi, class Sched, bool ALIGN_EPI = false, bool SP2 = false>
__device__ __forceinline__ void gemm_phase(PG8_LAS unsigned char* lds, const Gemm g, const Sched& S, const Epi& E) {
    int tid_ = threadIdx.x; asm volatile("" : "+v"(tid_));
    const int tid = tid_, wid = __builtin_amdgcn_readfirstlane(tid >> 6), lane = tid & 63, wr = wid >> 2, wc = wid & 3, fr = lane & 15, fq = lane >> 4;
    const int K = g.K, nt = K / BK;
    unsigned voffA[2], voffB[2];
#pragma unroll
    for (int i = 0; i < 2; ++i) { int R, C; stage_rc(tid * 16 + i * 8192, R, C); const int Rb = Epi::PERM ? ((R & ~31) + perm32(R & 31)) : R;
        voffA[i] = (unsigned)(R * g.lda + C) * 2u; voffB[i] = (unsigned)(Rb * g.ldb + C) * 2u; }
    const size_t kstep = (size_t)(BK * 2);
    const size_t hstepA = (size_t)HALF * g.lda * 2, hstepB = (size_t)HALF * g.ldb * 2;
    const size_t tstepA = 2 * hstepA, tstepB = 2 * hstepB;
    const unsigned ldsw = (unsigned)wid * 1024u;
    const int aoff = lds_byte(wr * 64 + fr, fq * 8), boff = lds_byte(wc * 32 + fr, fq * 8);
#define PG8_SA(b, h) (((b) * 2 + (h)) * HTB)
#define PG8_SB(b, h) ((4 + (b) * 2 + (h)) * HTB)
#define PG8_STAGE(bufoff, gbase, voff) do { _Pragma("unroll") for (int _i = 0; _i < 2; ++_i) \
        __builtin_amdgcn_global_load_lds((const unsigned*)((const char*)(gbase) + (voff)[_i]), (PG8_LAS unsigned*)(lds + (bufoff) + ldsw + _i * 8192), 16, 0, 0); } while (0)
#define PG8_LDA(dst, b, h) do { _Pragma("unroll") for (int m = 0; m < 4; ++m) _Pragma("unroll") for (int k = 0; k < 2; ++k) dst[m][k] = *(const PG8_LAS bf16x8*)(lds + PG8_SA(b, h) + aoff + m * 2048 + k * 1024); } while (0)
#define PG8_LDB(dst, b, h) do { _Pragma("unroll") for (int n = 0; n < 2; ++n) _Pragma("unroll") for (int k = 0; k < 2; ++k) dst[n][k] = *(const PG8_LAS bf16x8*)(lds + PG8_SB(b, h) + boff + n * 2048 + k * 1024); } while (0)
#define PG8_MMA(ai, bj, At, Bt) do { __builtin_amdgcn_s_setprio(1); _Pragma("unroll") for (int m = 0; m < 4; ++m) _Pragma("unroll") for (int n = 0; n < 2; ++n) _Pragma("unroll") for (int k = 0; k < 2; ++k) \
        acc[ai][bj][m][n] = __builtin_amdgcn_mfma_f32_16x16x32_bf16(Bt[n][k], At[m][k], acc[ai][bj][m][n], 0, 0, 0); __builtin_amdgcn_s_setprio(0); } while (0)
#define PG8_WAIT_V(n) asm volatile("s_waitcnt vmcnt(" #n ")" ::: "memory")
#define PG8_WAIT_L(n) asm volatile("s_waitcnt lgkmcnt(" #n ")" ::: "memory")
#define PG8_BAR __builtin_amdgcn_s_barrier()
#define PG8_SCHED __builtin_amdgcn_sched_barrier(0)
    Unit cur, nxt; int ui = 0;
    if (!S.next(0, cur)) return;
    f32x4 acc[2][2][4][2];
#pragma unroll
    for (int a = 0; a < 2; ++a)
#pragma unroll
        for (int b = 0; b < 2; ++b)
#pragma unroll
            for (int m = 0; m < 4; ++m)
#pragma unroll
                for (int n = 0; n < 2; ++n) acc[a][b][m][n] = (f32x4){0.f, 0.f, 0.f, 0.f};
    bf16x8 At[4][2], B0[2][2], B1[2][2];
    const char* cA = (const char*)g.A + (size_t)cur.pm * tstepA; const char* cB = (const char*)g.Bt + (size_t)cur.pn * tstepB;
    S.a_ready(cur);
    if constexpr (SP2) {
        PG8_STAGE(PG8_SB(0, 0), cB, voffB); PG8_STAGE(PG8_SB(0, 1), cB + hstepB, voffB); PG8_STAGE(PG8_SA(0, 0), cA, voffA); PG8_STAGE(PG8_SA(0, 1), cA + hstepA, voffA);
        if (wr == 1) PG8_BAR;
        PG8_WAIT_V(2); PG8_BAR;
        PG8_STAGE(PG8_SB(1, 0), cB + kstep, voffB); PG8_STAGE(PG8_SA(1, 0), cA + kstep, voffA); PG8_STAGE(PG8_SB(1, 1), cB + hstepB + kstep, voffB);
        PG8_WAIT_V(6); PG8_BAR;
    } else {
        PG8_STAGE(PG8_SB(0, 0), cB, voffB); PG8_STAGE(PG8_SA(0, 0), cA, voffA); PG8_STAGE(PG8_SB(0, 1), cB + hstepB, voffB); PG8_STAGE(PG8_SA(0, 1), cA + hstepA, voffA);
        if (wr == 1) PG8_BAR;
        PG8_WAIT_V(4); PG8_BAR;
        PG8_STAGE(PG8_SB(1, 0), cB + kstep, voffB); PG8_STAGE(PG8_SA(1, 0), cA + kstep, voffA); PG8_STAGE(PG8_SB(1, 1), cB + hstepB + kstep, voffB);
        PG8_WAIT_V(6); PG8_BAR;
    }
    for (;;) {
        const bool has_next = S.next(ui + 1, nxt);
        const char* nA = has_next ? (const char*)g.A + (size_t)nxt.pm * tstepA : cA; const char* nB = has_next ? (const char*)g.Bt + (size_t)nxt.pn * tstepB : cB;
        for (int t = 0; t < nt; t += 2) {
            const bool last = (t == nt - 2);
            const char* a1 = cA + (size_t)(t + 1) * kstep;
            const char* a2 = last ? nA : cA + (size_t)(t + 2) * kstep; const char* b2 = last ? nB : cB + (size_t)(t + 2) * kstep;
            const char* a3 = a2 + kstep; const char* b3 = b2 + kstep;
            if (last && has_next) S.a_ready(nxt);
            if constexpr (SP2) {
            PG8_LDB(B0, 0, 0); PG8_LDB(B1, 0, 1); PG8_SCHED; PG8_LDA(At, 0, 0); PG8_STAGE(PG8_SA(1, 1), a1 + hstepA, voffA);
            PG8_WAIT_V(8); PG8_WAIT_L(0); PG8_BAR; PG8_MMA(0, 0, At, B0); PG8_MMA(0, 1, At, B1); PG8_BAR; PG8_SCHED;
            PG8_LDA(At, 0, 1); PG8_STAGE(PG8_SB(0, 0), b2, voffB); PG8_STAGE(PG8_SB(0, 1), b2 + hstepB, voffB); PG8_STAGE(PG8_SA(0, 0), a2, voffA);
            PG8_WAIT_V(8); PG8_WAIT_L(0); PG8_BAR; PG8_MMA(1, 0, At, B0); PG8_MMA(1, 1, At, B1); PG8_BAR; PG8_SCHED;
            PG8_LDB(B0, 1, 0); PG8_LDB(B1, 1, 1); PG8_SCHED; PG8_LDA(At, 1, 0); PG8_STAGE(PG8_SA(0, 1), a2 + hstepA, voffA);
            PG8_WAIT_V(8); PG8_WAIT_L(0); PG8_BAR; PG8_MMA(0, 0, At, B0); PG8_MMA(0, 1, At, B1); PG8_BAR; PG8_SCHED;
            PG8_LDA(At, 1, 1); PG8_STAGE(PG8_SB(1, 0), b3, voffB); PG8_STAGE(PG8_SB(1, 1), b3 + hstepB, voffB); PG8_STAGE(PG8_SA(1, 0), a3, voffA);
            PG8_WAIT_V(8); PG8_WAIT_L(0); PG8_BAR; PG8_MMA(1, 0, At, B0); PG8_MMA(1, 1, At, B1); PG8_BAR; PG8_SCHED;
            } else {
            PG8_LDB(B0, 0, 0); PG8_SCHED; PG8_LDA(At, 0, 0); PG8_STAGE(PG8_SA(1, 1), a1 + hstepA, voffA);
            PG8_WAIT_L(8); PG8_BAR; PG8_WAIT_L(0); PG8_MMA(0, 0, At, B0); PG8_BAR; PG8_SCHED;
            PG8_LDB(B1, 0, 1); PG8_STAGE(PG8_SB(0, 0), b2, voffB);
            PG8_BAR; PG8_WAIT_L(0); PG8_MMA(0, 1, At, B1); PG8_BAR;
            PG8_LDA(At, 0, 1); PG8_STAGE(PG8_SA(0, 0), a2, voffA);
            PG8_BAR; PG8_WAIT_L(0); PG8_MMA(1, 0, At, B0); PG8_BAR; PG8_SCHED;
            PG8_STAGE(PG8_SB(0, 1), b2 + hstepB, voffB);
            PG8_WAIT_V(6); PG8_BAR; PG8_MMA(1, 1, At, B1); PG8_BAR;
            PG8_LDB(B0, 1, 0); PG8_SCHED; PG8_LDA(At, 1, 0); PG8_STAGE(PG8_SA(0, 1), a2 + hstepA, voffA);
            PG8_WAIT_L(8); PG8_BAR; PG8_WAIT_L(0); PG8_MMA(0, 0, At, B0); PG8_BAR; PG8_SCHED;
            PG8_LDB(B1, 1, 1); PG8_STAGE(PG8_SB(1, 0), b3, voffB);
            PG8_BAR; PG8_WAIT_L(0); PG8_MMA(0, 1, At, B1); PG8_BAR;
            PG8_LDA(At, 1, 1); PG8_STAGE(PG8_SA(1, 0), a3, voffA);
            PG8_BAR; PG8_WAIT_L(0); PG8_MMA(1, 0, At, B0); PG8_BAR; PG8_SCHED;
            PG8_STAGE(PG8_SB(1, 1), b3 + hstepB, voffB);
            PG8_WAIT_V(6); PG8_BAR; PG8_MMA(1, 1, At, B1); PG8_BAR;
            }
        }
        if constexpr (ALIGN_EPI) { if (wr == 0) PG8_BAR; }
        if constexpr (!Epi::AFTER_DRAIN) { E(acc, cur, wr, wc, fr, fq); S.done(cur); }
        if (!has_next) break;
#pragma unroll
        for (int a = 0; a < 2; ++a)
#pragma unroll
            for (int b = 0; b < 2; ++b)
#pragma unroll
                for (int m = 0; m < 4; ++m)
#pragma unroll
                    for (int n = 0; n < 2; ++n) acc[a][b][m][n] = (f32x4){0.f, 0.f, 0.f, 0.f};
        cur = nxt; cA = nA; cB = nB; ++ui;
        if constexpr (ALIGN_EPI) { if (wr == 1) PG8_BAR; }
    }
    PG8_WAIT_V(0);
    if constexpr (!ALIGN_EPI) { if (wr == 0) PG8_BAR; }
    PG8_BAR;
    if constexpr (Epi::AFTER_DRAIN) { E.fused(acc, cur, wr, wc, fr, fq, lds, wid, lane); S.done(cur); }
#undef PG8_SA
#undef PG8_SB
#undef PG8_STAGE
#undef PG8_LDA
#undef PG8_LDB
#undef PG8_MMA
#undef PG8_WAIT_V
#undef PG8_WAIT_L
#undef PG8_BAR
#undef PG8_SCHED
}
}
namespace fa {
typedef unsigned short bf16_t;
typedef short bf16x8 __attribute__((ext_vector_type(8)));
typedef float f32x16 __attribute__((ext_vector_type(16)));
typedef unsigned u32x4 __attribute__((ext_vector_type(4)));
typedef unsigned u32x2 __attribute__((ext_vector_type(2)));
typedef float f32x2_t __attribute__((ext_vector_type(2))); typedef __bf16 bf16x2_t __attribute__((ext_vector_type(2)));
#define FLAS __attribute__((address_space(3)))
#define FA_SB() __builtin_amdgcn_sched_barrier(0)
constexpr int SEQ = 8192, MTOK = 32768;
constexpr int LUT_N = 2688, LUT_C = 1344;
constexpr int KBUF = 8192, VPITCH = 144, VBUF = 128 * VPITCH;
constexpr int L_K = 0, L_V = 2 * KBUF, L_LUT = L_V + 2 * VBUF, L_END = L_LUT + LUT_N * 4;
__device__ __forceinline__ unsigned cvtpk(float lo, float hi) { f32x2_t v = {lo, hi}; bf16x2_t b = __builtin_convertvector(v, bf16x2_t); return __builtin_bit_cast(unsigned, b); }
__device__ __forceinline__ void xswap(unsigned& a, unsigned& b) { asm volatile("s_nop 1\n\tv_permlane32_swap_b32 %0, %1\n\ts_nop 1" : "+v"(a), "+v"(b)); }
__device__ __forceinline__ float fadd_s(float a, float b) { float r; asm("v_add_f32_e32 %0, %1, %2" : "=v"(r) : "v"(a), "v"(b)); return r; }
__device__ __forceinline__ float xhalf_max(float m) { unsigned a = __builtin_bit_cast(unsigned, m), b = a; xswap(a, b); return __builtin_fmaxf(__builtin_bit_cast(float, a), __builtin_bit_cast(float, b)); }
__device__ __forceinline__ float xhalf_sum(float m) { unsigned a = __builtin_bit_cast(unsigned, m), b = a; xswap(a, b); return __builtin_bit_cast(float, a) + __builtin_bit_cast(float, b); }

struct Unit {
    const bf16_t* Q;
    const bf16_t* K;
    const bf16_t* VT;
    bf16_t* O;
    const float* lut;
    int ldq, ldk, ldo;
    int tok0;
    int q0;
    int t_lo, t_hi;
    int load_lut;
};

template <int MODE> __device__ __forceinline__ void attn_unit(FLAS unsigned char* lds, const Unit u) {
    constexpr int DV = (MODE == 0) ? 128 : 64, NDB = DV / 32, NVR = DV / 64;
    int tid_ = threadIdx.x; asm volatile("" : "+v"(tid_));
    const int tid = tid_, lane = tid & 63, r32 = lane & 31, hi = lane >> 5; const int wid = __builtin_amdgcn_readfirstlane(tid >> 6);
    const int q0w = u.q0 + 32 * wid;
    const int q = q0w + r32;
    if (u.load_lut) { FLAS float* L = (FLAS float*)(lds + L_LUT); const int n = (MODE == 1) ? 15 * 128 : LUT_N; for (int i = tid; i < n; i += 512) L[i] = u.lut[i]; }
    bf16x8 qr[4];
    { const bf16_t* qp = u.Q + (size_t)(u.tok0 + q) * u.ldq + hi * 8;
#pragma unroll
      for (int d0 = 0; d0 < 4; ++d0) qr[d0] = *(const bf16x8*)(qp + d0 * 16); }
    const bf16_t* ksrc = u.K + (size_t)(u.tok0 + (tid >> 3)) * u.ldk + (tid & 7) * 8;
    const bf16_t* vsrc = u.VT + (size_t)(tid >> 3) * MTOK + u.tok0 + (tid & 7) * 8;
    const int kdst = (tid & 7) * 1024 + (((tid >> 3) ^ (tid & 7)) * 16), vdst = (tid >> 3) * VPITCH + ((tid & 7) >> 1) * 32 + (tid & 1) * 8;
    u32x4 kreg, vreg[NVR];
    kreg = *(const u32x4*)(ksrc + (size_t)u.t_lo * 64 * u.ldk);
#pragma unroll
    for (int i = 0; i < NVR; ++i) vreg[i] = *(const u32x4*)(vsrc + (size_t)i * 64 * MTOK + u.t_lo * 64);
    *(FLAS u32x4*)(lds + L_K + kdst) = kreg;
#pragma unroll
    for (int i = 0; i < NVR; ++i) { *(FLAS u32x2*)(lds + L_V + vdst + i * 64 * VPITCH) = (u32x2){vreg[i].x, vreg[i].y}; *(FLAS u32x2*)(lds + L_V + vdst + i * 64 * VPITCH + 16) = (u32x2){vreg[i].z, vreg[i].w}; }
    __syncthreads();
    f32x16 o[NDB];
#pragma unroll
    for (int i = 0; i < NDB; ++i) o[i] = (f32x16){0.f,0.f,0.f,0.f,0.f,0.f,0.f,0.f,0.f,0.f,0.f,0.f,0.f,0.f,0.f,0.f};
    float mrun = 0.f, lsum = 0.f; bool first = true;
    const float NEG = -3.0e38f;
    const FLAS float* L = (const FLAS float*)(lds + L_LUT);
    const int gi = (u.q0 >> 6) + (wid >> 1);
    const int qc = 32 * (wid & 1) + r32;
    const int rstart = gi - 4 < 0 ? 0 : (gi - 4 > 120 ? 120 : gi - 4);
    const int cstart = qc - 8 < 0 ? 0 : (qc - 8 > 48 ? 48 : qc - 8);
    for (int t = u.t_lo; t < u.t_hi; ++t) {
        const int cur = (t - u.t_lo) & 1;
        const bool more = (t + 1 < u.t_hi);
        if (more) { kreg = *(const u32x4*)(ksrc + (size_t)(t + 1) * 64 * u.ldk);
#pragma unroll
            for (int i = 0; i < NVR; ++i) vreg[i] = *(const u32x4*)(vsrc + (size_t)i * 64 * MTOK + (t + 1) * 64); }
        const int k0 = t * 64;
        bool active = true;
        if (MODE == 1) active = (t >= rstart) && (t < rstart + 8);
        if (MODE == 2) active = (k0 + 63 >= q0w - 1024) && (k0 <= q0w + 31 + 1024);
        if (active) {
            f32x16 p0, p1;
            bf16x8 kf[8];
            { const FLAS unsigned char* kb = lds + L_K + cur * KBUF;
#pragma unroll
              for (int d0 = 0; d0 < 4; ++d0) { const int ko = (2 * d0 + hi) * 1024 + ((r32 ^ (2 * d0 + hi)) * 16); kf[2 * d0] = *(const FLAS bf16x8*)(kb + ko); kf[2 * d0 + 1] = *(const FLAS bf16x8*)(kb + ko + 512); } }
            float cb = 0.f; bool zinit = false;
            if (MODE == 0) { const int dmin = k0 - (q0w + 31), dmax = k0 + 63 - q0w;
                if (dmin >= 559) { cb = L[LUT_C + 600]; zinit = true; } else if (dmax <= -559) { cb = L[LUT_C - 600]; zinit = true; } }
            if (zinit) {
                const f32x16 z16 = {0.f,0.f,0.f,0.f,0.f,0.f,0.f,0.f,0.f,0.f,0.f,0.f,0.f,0.f,0.f,0.f};
                FA_SB();
                p0 = __builtin_amdgcn_mfma_f32_32x32x16_bf16(kf[0], qr[0], z16, 0, 0, 0); p1 = __builtin_amdgcn_mfma_f32_32x32x16_bf16(kf[1], qr[0], z16, 0, 0, 0);
#pragma unroll
                for (int d0 = 1; d0 < 4; ++d0) { p0 = __builtin_amdgcn_mfma_f32_32x32x16_bf16(kf[2 * d0], qr[d0], p0, 0, 0, 0); p1 = __builtin_amdgcn_mfma_f32_32x32x16_bf16(kf[2 * d0 + 1], qr[d0], p1, 0, 0, 0); }
            } else {
                if (MODE == 0 || MODE == 2) { const FLAS float* lp = L + (k0 - q + LUT_C + 4 * hi);
#pragma unroll
                    for (int r = 0; r < 16; ++r) { p0[r] = lp[(r & 3) + 8 * (r >> 2)]; p1[r] = lp[32 + (r & 3) + 8 * (r >> 2)]; }
                } else { const FLAS float* lp = L + ((t - gi + 7) * 128 + 63 - qc + 4 * hi);
#pragma unroll
                    for (int r = 0; r < 16; ++r) { const int kc = (r & 3) + 8 * (r >> 2) + 4 * hi;
                        const float v0 = lp[(r & 3) + 8 * (r >> 2)], v1 = lp[32 + (r & 3) + 8 * (r >> 2)];
                        p0[r] = ((unsigned)(kc - cstart) < 16u) ? v0 : NEG; p1[r] = ((unsigned)(kc + 32 - cstart) < 16u) ? v1 : NEG; } }
                FA_SB();
#pragma unroll
                for (int d0 = 0; d0 < 4; ++d0) { p0 = __builtin_amdgcn_mfma_f32_32x32x16_bf16(kf[2 * d0], qr[d0], p0, 0, 0, 0); p1 = __builtin_amdgcn_mfma_f32_32x32x16_bf16(kf[2 * d0 + 1], qr[d0], p1, 0, 0, 0); }
            }
            const FLAS unsigned char* vb = lds + L_V + cur * VBUF + r32 * VPITCH + hi * 16;
            u32x4 vf[2][NDB];
#pragma unroll
            for (int db = 0; db < NDB; ++db) vf[0][db] = *(const FLAS u32x4*)(vb + db * 32 * VPITCH);
            FA_SB();
            const float off = cb - mrun;
#pragma unroll
            for (int r = 0; r < 16; ++r) { p0[r] = p0[r] + off; p1[r] = p1[r] + off; }
            float rm = __builtin_fmaxf(p0[0], p1[0]);
#pragma unroll
            for (int r = 1; r < 16; ++r) rm = __builtin_fmaxf(rm, __builtin_fmaxf(p0[r], p1[r]));
            rm = xhalf_max(rm);
            if (first) {
                const float dl = __builtin_fmaxf(rm, -1000.0f); mrun = dl;
#pragma unroll
                for (int r = 0; r < 16; ++r) { p0[r] = p0[r] - dl; p1[r] = p1[r] - dl; }
                first = false;
            } else if (__any(rm > 8.0f)) { const float dl = __builtin_fmaxf(rm, 0.0f); const float f = __builtin_amdgcn_exp2f(-dl); mrun += dl; lsum *= f;
#pragma unroll
                for (int i = 0; i < NDB; ++i) o[i] = o[i] * f;
#pragma unroll
                for (int r = 0; r < 16; ++r) { p0[r] = p0[r] - dl; p1[r] = p1[r] - dl; } }
            float ps = 0.f;
#pragma unroll
            for (int r = 0; r < 16; ++r) { p0[r] = __builtin_amdgcn_exp2f(p0[r]); p1[r] = __builtin_amdgcn_exp2f(p1[r]); ps += p0[r] + p1[r]; }
            lsum += ps;
            u32x4 pw[4];
            pw[0] = (u32x4){cvtpk(p0[0], p0[1]), cvtpk(p0[2], p0[3]), cvtpk(p0[4], p0[5]), cvtpk(p0[6], p0[7])};
            pw[1] = (u32x4){cvtpk(p0[8], p0[9]), cvtpk(p0[10], p0[11]), cvtpk(p0[12], p0[13]), cvtpk(p0[14], p0[15])};
            pw[2] = (u32x4){cvtpk(p1[0], p1[1]), cvtpk(p1[2], p1[3]), cvtpk(p1[4], p1[5]), cvtpk(p1[6], p1[7])};
            pw[3] = (u32x4){cvtpk(p1[8], p1[9]), cvtpk(p1[10], p1[11]), cvtpk(p1[12], p1[13]), cvtpk(p1[14], p1[15])};
            FA_SB();
#pragma unroll
            for (int s = 0; s < 4; ++s) {
                if (s < 3) {
#pragma unroll
                    for (int db = 0; db < NDB; ++db) vf[(s + 1) & 1][db] = *(const FLAS u32x4*)(vb + db * 32 * VPITCH + (s + 1) * 32); }
#pragma unroll
                for (int db = 0; db < NDB; ++db) o[db] = __builtin_amdgcn_mfma_f32_32x32x16_bf16(__builtin_bit_cast(bf16x8, vf[s & 1][db]), __builtin_bit_cast(bf16x8, pw[s]), o[db], 0, 0, 0);
                FA_SB();
            }
        }
        if (more) { *(FLAS u32x4*)(lds + L_K + (cur ^ 1) * KBUF + kdst) = kreg;
#pragma unroll
            for (int i = 0; i < NVR; ++i) { *(FLAS u32x2*)(lds + L_V + (cur ^ 1) * VBUF + vdst + i * 64 * VPITCH) = (u32x2){vreg[i].x, vreg[i].y}; *(FLAS u32x2*)(lds + L_V + (cur ^ 1) * VBUF + vdst + i * 64 * VPITCH + 16) = (u32x2){vreg[i].z, vreg[i].w}; } }
        __syncthreads();
    }
    const float inv = 1.0f / xhalf_sum(lsum);
    bf16_t* op = u.O + (size_t)(u.tok0 + q) * u.ldo + 4 * hi;
#pragma unroll
    for (int db = 0; db < NDB; ++db)
#pragma unroll
        for (int g = 0; g < 4; ++g) { u32x2 w; w.x = cvtpk(o[db][4 * g] * inv, o[db][4 * g + 1] * inv); w.y = cvtpk(o[db][4 * g + 2] * inv, o[db][4 * g + 3] * inv);
            *(u32x2*)(op + db * 32 + 8 * g) = w; }
}

constexpr int LA_K = 0, LA_V = 2 * KBUF, LA_LUT = LA_V + 4 * VBUF, LA_END = LA_LUT + LUT_N * 4;
__device__ __forceinline__ void attn_unit_a(FLAS unsigned char* lds, const Unit u) {
    constexpr int NDB = 4;
    int tid_ = threadIdx.x; asm volatile("" : "+v"(tid_));
    const int tid = tid_, lane = tid & 63, r32 = lane & 31, hi = lane >> 5; const int wid = __builtin_amdgcn_readfirstlane(tid >> 6);
    const int q0w = u.q0 + 32 * wid, q = q0w + r32;
    if (u.load_lut) { FLAS float* Lw = (FLAS float*)(lds + LA_LUT); for (int i = tid; i < LUT_N; i += 512) Lw[i] = u.lut[i]; }
    bf16x8 qr[4];
    { const bf16_t* qp = u.Q + (size_t)(u.tok0 + q) * u.ldq + hi * 8;
#pragma unroll
      for (int d0 = 0; d0 < 4; ++d0) qr[d0] = *(const bf16x8*)(qp + d0 * 16); }
    const bf16_t* ksrc = u.K + (size_t)(u.tok0 + (tid >> 3)) * u.ldk + (tid & 7) * 8;
    const bf16_t* vsrc = u.VT + (size_t)(tid >> 3) * MTOK + u.tok0 + (tid & 7) * 8;
    const int kdst = (tid & 7) * 1024 + (((tid >> 3) ^ (tid & 7)) * 16), vdst = (tid >> 3) * VPITCH + ((tid & 7) >> 1) * 32 + (tid & 1) * 8;
    const int NT = u.t_hi - u.t_lo;
    u32x4 kreg, vreg[2];
#pragma unroll
    for (int j = 0; j < 2; ++j) {
        kreg = *(const u32x4*)(ksrc + (size_t)(u.t_lo + j) * 64 * u.ldk);
#pragma unroll
        for (int i = 0; i < 2; ++i) vreg[i] = *(const u32x4*)(vsrc + (size_t)i * 64 * MTOK + (u.t_lo + j) * 64);
        *(FLAS u32x4*)(lds + LA_K + j * KBUF + kdst) = kreg;
#pragma unroll
        for (int i = 0; i < 2; ++i) { *(FLAS u32x2*)(lds + LA_V + j * VBUF + vdst + i * 64 * VPITCH) = (u32x2){vreg[i].x, vreg[i].y}; *(FLAS u32x2*)(lds + LA_V + j * VBUF + vdst + i * 64 * VPITCH + 16) = (u32x2){vreg[i].z, vreg[i].w}; } }
    __syncthreads();
    const FLAS float* L = (const FLAS float*)(lds + LA_LUT);
    const f32x16 z16 = {0.f,0.f,0.f,0.f,0.f,0.f,0.f,0.f,0.f,0.f,0.f,0.f,0.f,0.f,0.f,0.f};
    f32x16 o[NDB];
#pragma unroll
    for (int i = 0; i < NDB; ++i) o[i] = z16;
    float mrun = 0.f, lsum = 0.f, fpend = 1.f; bool first = true, pend = false;
#define FA_BIAS(I, P0, P1, CB, ZI) do { const int k0_ = (u.t_lo + (I)) * 64; const int dmin_ = k0_ - (q0w + 31), dmax_ = k0_ + 63 - q0w; CB = 0.f; ZI = false; \
        if (dmin_ >= 559) { CB = L[LUT_C + 600]; ZI = true; } else if (dmax_ <= -559) { CB = L[LUT_C - 600]; ZI = true; } \
        else { const FLAS float* lp_ = L + (k0_ - q + LUT_C + 4 * hi); _Pragma("unroll") for (int r = 0; r < 16; ++r) { P0[r] = lp_[(r & 3) + 8 * (r >> 2)]; P1[r] = lp_[32 + (r & 3) + 8 * (r >> 2)]; } } } while (0)
#define FA_VFRAG(M) (*(const FLAS u32x4*)(vb_ + ((M) & 3) * 32 * VPITCH + ((M) >> 2) * 32))
#define FA_PVP(VSLOT, PW) do { const FLAS unsigned char* vb_ = lds + LA_V + (VSLOT) * VBUF + r32 * VPITCH + hi * 16; u32x4 vr_[4]; \
        _Pragma("unroll") for (int m_ = 0; m_ < 4; ++m_) vr_[m_] = FA_VFRAG(m_); \
        FA_SB(); \
        _Pragma("unroll") for (int m_ = 0; m_ < 16; ++m_) { \
            o[m_ & 3] = __builtin_amdgcn_mfma_f32_32x32x16_bf16(__builtin_bit_cast(bf16x8, vr_[m_ & 3]), __builtin_bit_cast(bf16x8, PW[m_ >> 2]), o[m_ & 3], 0, 0, 0); \
            if (m_ + 4 < 16) vr_[m_ & 3] = FA_VFRAG(m_ + 4); \
            FA_SB(); } } while (0)
    f32x16 pa0, pa1, pb0, pb1; float cbC = 0.f;
    { bool zi; FA_BIAS(0, pa0, pa1, cbC, zi); if (zi) { pa0 = z16; pa1 = z16; }
      const FLAS unsigned char* kb = lds + LA_K;
#pragma unroll
      for (int d0 = 0; d0 < 4; ++d0) { const int ko = (2 * d0 + hi) * 1024 + ((r32 ^ (2 * d0 + hi)) * 16); const bf16x8 a0 = *(const FLAS bf16x8*)(kb + ko), a1 = *(const FLAS bf16x8*)(kb + ko + 512);
          pa0 = __builtin_amdgcn_mfma_f32_32x32x16_bf16(a0, qr[d0], pa0, 0, 0, 0); pa1 = __builtin_amdgcn_mfma_f32_32x32x16_bf16(a1, qr[d0], pa1, 0, 0, 0); } }
    u32x4 pwa[4] = {{0u,0u,0u,0u},{0u,0u,0u,0u},{0u,0u,0u,0u},{0u,0u,0u,0u}}, pwb[4] = {{0u,0u,0u,0u},{0u,0u,0u,0u},{0u,0u,0u,0u},{0u,0u,0u,0u}};
    auto step = [&](const int i, f32x16& pC0, f32x16& pC1, f32x16& pN0, f32x16& pN1, u32x4 (&PWC)[4], u32x4 (&PWN)[4]) __attribute__((always_inline)) {
        if (pend) {
#pragma unroll
            for (int d = 0; d < NDB; ++d) o[d] = o[d] * fpend;
            pend = false; }
        if (i + 2 < NT) { kreg = *(const u32x4*)(ksrc + (size_t)(u.t_lo + i + 2) * 64 * u.ldk);
#pragma unroll
            for (int j = 0; j < 2; ++j) vreg[j] = *(const u32x4*)(vsrc + (size_t)j * 64 * MTOK + (u.t_lo + i + 2) * 64); }
        const int vsp = (i == 0) ? 0 : ((i - 1) & 3);
        const FLAS unsigned char* vb_ = lds + LA_V + vsp * VBUF + r32 * VPITCH + hi * 16;
        const FLAS unsigned char* kb = lds + LA_K + ((i + 1) & 1) * KBUF;
#define FA_KF(D0, H) (*(const FLAS bf16x8*)(kb + ((2 * (D0) + hi) * 1024 + ((r32 ^ (2 * (D0) + hi)) * 16)) + (H) * 512))
#define FA_PVM(G) do { o[(G) & 3] = __builtin_amdgcn_mfma_f32_32x32x16_bf16(__builtin_bit_cast(bf16x8, vr[(G) % 3]), __builtin_bit_cast(bf16x8, PWC[(G) >> 2]), o[(G) & 3], 0, 0, 0); if ((G) + 3 < 16) vr[(G) % 3] = FA_VFRAG((G) + 3); } while (0)
#define FA_EXP2(J, PX, R) do { const float e0_ = __builtin_amdgcn_exp2f(PX[R]), e1_ = __builtin_amdgcn_exp2f(PX[(R) + 1]); ps += e0_; ps += e1_; PWN[(J) >> 2][(J) & 3] = cvtpk(e0_, e1_); } while (0)
        u32x4 vr[3];
#pragma unroll
        for (int m = 0; m < 3; ++m) vr[m] = FA_VFRAG(m);
        const float off = cbC - mrun;
        FA_SB();
        float ra, rb, rm;
        FA_PVM(0); pC0[0] = fadd_s(pC0[0], off); pC1[0] = fadd_s(pC1[0], off); pC0[1] = fadd_s(pC0[1], off); pC1[1] = fadd_s(pC1[1], off); pC0[2] = fadd_s(pC0[2], off); pC1[2] = fadd_s(pC1[2], off); FA_SB();
        FA_PVM(1); ra = __builtin_fmaxf(__builtin_fmaxf(pC0[0], pC0[1]), pC0[2]); rb = __builtin_fmaxf(__builtin_fmaxf(pC1[0], pC1[1]), pC1[2]); pC0[3] = fadd_s(pC0[3], off); pC1[3] = fadd_s(pC1[3], off); pC0[4] = fadd_s(pC0[4], off); pC1[4] = fadd_s(pC1[4], off); FA_SB();
        FA_PVM(2); ra = __builtin_fmaxf(__builtin_fmaxf(ra, pC0[3]), pC0[4]); rb = __builtin_fmaxf(__builtin_fmaxf(rb, pC1[3]), pC1[4]); pC0[5] = fadd_s(pC0[5], off); pC1[5] = fadd_s(pC1[5], off); pC0[6] = fadd_s(pC0[6], off); pC1[6] = fadd_s(pC1[6], off); FA_SB();
        FA_PVM(3); ra = __builtin_fmaxf(__builtin_fmaxf(ra, pC0[5]), pC0[6]); rb = __builtin_fmaxf(__builtin_fmaxf(rb, pC1[5]), pC1[6]); pC0[7] = fadd_s(pC0[7], off); pC1[7] = fadd_s(pC1[7], off); pC0[8] = fadd_s(pC0[8], off); pC1[8] = fadd_s(pC1[8], off); FA_SB();
        FA_PVM(4); ra = __builtin_fmaxf(__builtin_fmaxf(ra, pC0[7]), pC0[8]); rb = __builtin_fmaxf(__builtin_fmaxf(rb, pC1[7]), pC1[8]); pC0[9] = fadd_s(pC0[9], off); pC1[9] = fadd_s(pC1[9], off); pC0[10] = fadd_s(pC0[10], off); pC1[10] = fadd_s(pC1[10], off); FA_SB();
        FA_PVM(5); ra = __builtin_fmaxf(__builtin_fmaxf(ra, pC0[9]), pC0[10]); rb = __builtin_fmaxf(__builtin_fmaxf(rb, pC1[9]), pC1[10]); pC0[11] = fadd_s(pC0[11], off); pC1[11] = fadd_s(pC1[11], off); pC0[12] = fadd_s(pC0[12], off); pC1[12] = fadd_s(pC1[12], off); FA_SB();
        FA_PVM(6); ra = __builtin_fmaxf(__builtin_fmaxf(ra, pC0[11]), pC0[12]); rb = __builtin_fmaxf(__builtin_fmaxf(rb, pC1[11]), pC1[12]); pC0[13] = fadd_s(pC0[13], off); pC1[13] = fadd_s(pC1[13], off); pC0[14] = fadd_s(pC0[14], off); pC1[14] = fadd_s(pC1[14], off); FA_SB();
        FA_PVM(7); ra = __builtin_fmaxf(__builtin_fmaxf(ra, pC0[13]), pC0[14]); rb = __builtin_fmaxf(__builtin_fmaxf(rb, pC1[13]), pC1[14]); pC0[15] = fadd_s(pC0[15], off); pC1[15] = fadd_s(pC1[15], off); ra = __builtin_fmaxf(__builtin_fmaxf(ra, pC0[15]), pC1[15]); rm = __builtin_fmaxf(ra, rb); FA_SB();
        rm = xhalf_max(rm);
        FA_SB();
        if (first || __any(rm > 8.0f)) {
            const float dl = __builtin_fmaxf(rm, first ? -1000.0f : 0.0f); const float f = first ? 1.0f : __builtin_amdgcn_exp2f(-dl);
            mrun = first ? dl : mrun + dl; lsum *= f; fpend = f; pend = !first; first = false;
#pragma unroll
            for (int r = 0; r < 16; ++r) { pC0[r] = pC0[r] - dl; pC1[r] = pC1[r] - dl; }
        }
        float ps = 0.f;
        bf16x8 kf[4];
#pragma unroll
        for (int g = 8; g < 16; ++g) { FA_PVM(g); FA_EXP2(g - 8, pC0, 2 * (g - 8));
            if (g == 12) { kf[0] = FA_KF(0, 0); kf[1] = FA_KF(0, 1); kf[2] = FA_KF(1, 0); kf[3] = FA_KF(1, 1); }
            FA_SB(); }
        float cbN; bool ziN; const int inx = (i + 1 < NT) ? i + 1 : NT - 1;
        FA_BIAS(inx, pN0, pN1, cbN, ziN);
        FA_SB();
        if (ziN) { pN0 = __builtin_amdgcn_mfma_f32_32x32x16_bf16(kf[0], qr[0], z16, 0, 0, 0); FA_EXP2(8, pC1, 0); FA_SB(); pN1 = __builtin_amdgcn_mfma_f32_32x32x16_bf16(kf[1], qr[0], z16, 0, 0, 0); }
        else { pN0 = __builtin_amdgcn_mfma_f32_32x32x16_bf16(kf[0], qr[0], pN0, 0, 0, 0); FA_EXP2(8, pC1, 0); FA_SB(); pN1 = __builtin_amdgcn_mfma_f32_32x32x16_bf16(kf[1], qr[0], pN1, 0, 0, 0); }
        kf[0] = FA_KF(2, 0); kf[1] = FA_KF(2, 1); FA_EXP2(9, pC1, 2); FA_SB();
        pN0 = __builtin_amdgcn_mfma_f32_32x32x16_bf16(kf[2], qr[1], pN0, 0, 0, 0); FA_EXP2(10, pC1, 4); FA_SB();
        pN1 = __builtin_amdgcn_mfma_f32_32x32x16_bf16(kf[3], qr[1], pN1, 0, 0, 0); kf[2] = FA_KF(3, 0); kf[3] = FA_KF(3, 1); FA_EXP2(11, pC1, 6); FA_SB();
        pN0 = __builtin_amdgcn_mfma_f32_32x32x16_bf16(kf[0], qr[2], pN0, 0, 0, 0); FA_EXP2(12, pC1, 8); FA_SB();
        pN1 = __builtin_amdgcn_mfma_f32_32x32x16_bf16(kf[1], qr[2], pN1, 0, 0, 0); FA_EXP2(13, pC1, 10); FA_SB();
        pN0 = __builtin_amdgcn_mfma_f32_32x32x16_bf16(kf[2], qr[3], pN0, 0, 0, 0); FA_EXP2(14, pC1, 12); FA_SB();
        pN1 = __builtin_amdgcn_mfma_f32_32x32x16_bf16(kf[3], qr[3], pN1, 0, 0, 0); FA_EXP2(15, pC1, 14); FA_SB();
#undef FA_KF
#undef FA_PVM
#undef FA_EXP2
        lsum += ps; cbC = cbN;
        if (i + 2 < NT) { *(FLAS u32x4*)(lds + LA_K + (i & 1) * KBUF + kdst) = kreg;
#pragma unroll
            for (int j = 0; j < 2; ++j) { *(FLAS u32x2*)(lds + LA_V + ((i + 2) & 3) * VBUF + vdst + j * 64 * VPITCH) = (u32x2){vreg[j].x, vreg[j].y}; *(FLAS u32x2*)(lds + LA_V + ((i + 2) & 3) * VBUF + vdst + j * 64 * VPITCH + 16) = (u32x2){vreg[j].z, vreg[j].w}; } }
        __syncthreads();
    };
    for (int i = 0; i < NT; i += 2) { step(i, pa0, pa1, pb0, pb1, pwa, pwb); if (i + 1 < NT) step(i + 1, pb0, pb1, pa0, pa1, pwb, pwa); }
    if (pend) {
#pragma unroll
        for (int d = 0; d < NDB; ++d) o[d] = o[d] * fpend; }
    if (NT & 1) { FA_PVP((NT - 1) & 3, pwb); } else { FA_PVP((NT - 1) & 3, pwa); }
#undef FA_BIAS
#undef FA_PVP
#undef FA_VFRAG
    const float inv = 1.0f / xhalf_sum(lsum);
    bf16_t* op = u.O + (size_t)(u.tok0 + q) * u.ldo + 4 * hi;
#pragma unroll
    for (int db = 0; db < NDB; ++db)
#pragma unroll
        for (int g = 0; g < 4; ++g) { u32x2 w; w.x = cvtpk(o[db][4 * g] * inv, o[db][4 * g + 1] * inv); w.y = cvtpk(o[db][4 * g + 2] * inv, o[db][4 * g + 3] * inv);
            *(u32x2*)(op + db * 32 + 8 * g) = w; }
    __syncthreads();
}
}
#define LAS __attribute__((address_space(3)))
typedef unsigned short bf16;
typedef unsigned v4u __attribute__((ext_vector_type(4)));
typedef float f32x4 __attribute__((ext_vector_type(4)));
constexpr int NWAVES = 8;
constexpr int DM = 1024, BATCH = 4, SEQ = 8192, MTOK = BATCH * SEQ, DFF = 2816, INC = 7680, DEPTH = 2;
constexpr float EPS = 1e-6f, LOG2E = 1.4426950408889634f, QSCALE = 0.125f * 1.4426950408889634f;
constexpr size_t MiB = 1u << 20;
constexpr size_t WS_LUTA = 0;
constexpr size_t WS_LUTC = 64 * 1024;
constexpr size_t WS_LUTB = 192 * 1024;
constexpr size_t WS_W = 1 * MiB;
constexpr size_t W_13A = WS_W, W_2A = W_13A + 11 * MiB, W_13B = W_2A + 5632 * 1024, W_2B = W_13B + 11 * MiB;
constexpr size_t W_QK = W_2B + 5632 * 1024, W_V = W_QK + 6 * MiB, W_G = W_V + 3 * MiB, W_BR = W_G + 6 * MiB, W_O = W_BR + 3 * MiB, W_END = W_O + 2 * MiB;
static_assert(W_END == 54 * MiB, "weights");
constexpr size_t WS_XN = 54 * MiB;
constexpr size_t WS_QP = 118 * MiB;
constexpr size_t WS_KP = 214 * MiB;
constexpr size_t WS_VT = 310 * MiB;
constexpr size_t WS_O12 = 406 * MiB;
constexpr size_t WS_END = 470 * MiB;
constexpr size_t WS_U = WS_QP;
constexpr size_t WS_G = WS_KP;
constexpr int LDS_BYTES = 147456;
constexpr size_t WS_BAR = 512 * 1024, BAR_BYTES = 16384;
constexpr int LDS_MISC = 131072 + 64;
#define XB_TMO      128
#define XB_XCNT(j)  (256  + 64 * (j))
#define XB_XSUB(j)  (1280 + 64 * (j))
#define XB_XGEN(j)  (2304 + 64 * (j))
#define XB_TOP      3328
#define XB_TOPGEN   3392
#define XCD_BAR_WORDS 3456
#define XB_SPIN_CAP (1u << 18)

__device__ __forceinline__ unsigned xb_ld(unsigned* p)              { return __hip_atomic_load(p, __ATOMIC_RELAXED, __HIP_MEMORY_SCOPE_AGENT); }
__device__ __forceinline__ unsigned xb_add(unsigned* p, unsigned v) { return __hip_atomic_fetch_add(p, v, __ATOMIC_RELAXED, __HIP_MEMORY_SCOPE_AGENT); }
__device__ __forceinline__ unsigned xb_xcc_id() { return (unsigned)__builtin_amdgcn_s_getreg((3 << 11) | 20) & 0xFu; }
#define XB_SPIN(cond, bar) do { unsigned _sp = 0; while (cond) { __builtin_amdgcn_s_sleep(1); \
    if ((++_sp & 255u) == 0u) { if (xb_ld(&(bar)[XB_TMO])) break; if (_sp > XB_SPIN_CAP) { __hip_atomic_store(&(bar)[XB_TMO], 1u, __ATOMIC_RELAXED, __HIP_MEMORY_SCOPE_AGENT); break; } } } } while (0)

struct XcdBarrier {
    unsigned* bar; unsigned x;
    volatile LAS unsigned* st;
};

__device__ __forceinline__ XcdBarrier xcd_barrier_post(unsigned* bar, volatile LAS unsigned* st) {
    XcdBarrier b; b.bar = bar; b.x = xb_xcc_id(); b.st = st;
    if (threadIdx.x == 0) (void)xb_add(&bar[XB_XCNT(b.x)], 1u);
    return b;
}
__device__ __forceinline__ void xcd_barrier_complete(unsigned* bar, unsigned x, unsigned& nloc, unsigned& nx) {
    const unsigned G = gridDim.x * gridDim.y * gridDim.z;
    unsigned sum, cnt, mine, sp = 0u;
    for (;;) {
        sum = 0u; cnt = 0u; mine = 0u;
#pragma unroll
        for (unsigned j = 0; j < 16; ++j) { const unsigned c = xb_ld(&bar[XB_XCNT(j)]); sum += c; cnt += (c > 0u) ? 1u : 0u; mine = (j == x) ? c : mine; }
        if (sum == G) break;
        __builtin_amdgcn_s_sleep(1);
        if ((++sp & 255u) == 0u) { if (xb_ld(&bar[XB_TMO])) break; if (sp > XB_SPIN_CAP) { __hip_atomic_store(&bar[XB_TMO], 1u, __ATOMIC_RELAXED, __HIP_MEMORY_SCOPE_AGENT); break; } }
    }
    nloc = mine > 0u ? mine : 1u; nx = cnt > 0u ? cnt : 1u;
}

__device__ __forceinline__ void xcd_barrier(const XcdBarrier& b) {
    asm volatile("s_waitcnt vmcnt(0)" ::: "memory");
    __syncthreads();
    if (threadIdx.x == 0) {
        unsigned* bar = b.bar;
        __builtin_amdgcn_s_waitcnt(0);
        unsigned nloc = b.st[0], nx = b.st[1];
        if (nloc == 0u) { xcd_barrier_complete(bar, b.x, nloc, nx); b.st[0] = nloc; b.st[1] = nx; }
        const unsigned old = xb_add(&bar[XB_XSUB(b.x)], 1u);
        const unsigned gen = old / nloc;
        if (old + 1u == (gen + 1u) * nloc) {
            __builtin_amdgcn_fence(__ATOMIC_RELEASE, "agent");
            asm volatile("s_waitcnt vmcnt(0)" ::: "memory");
            const unsigned og = xb_add(&bar[XB_TOP], 1u);
            const unsigned tg = og / nx;
            if (og + 1u == (tg + 1u) * nx) xb_add(&bar[XB_TOPGEN], 1u);
            else XB_SPIN(xb_ld(&bar[XB_TOPGEN]) == tg, bar);
            __builtin_amdgcn_fence(__ATOMIC_ACQUIRE, "agent");
            xb_add(&bar[XB_XGEN(b.x)], 1u);
            asm volatile("s_waitcnt vmcnt(0)" ::: "memory");
        } else {
            XB_SPIN(xb_ld(&bar[XB_XGEN(b.x)]) == gen, bar);
            __builtin_amdgcn_fence(__ATOMIC_ACQUIRE, "agent");
            asm volatile("s_waitcnt vmcnt(0)" ::: "memory");
        }
    }
    __syncthreads();
}


#ifndef GACT
#define GACT 2
#endif
#ifndef BR_N
#define BR_N 3
#endif
#ifndef STOP_AFTER
#define STOP_AFTER 0
#endif
#ifndef PHASE_MASK
#define PHASE_MASK 0xFFFF
#endif
#define PH(b) ((PHASE_MASK >> (b)) & 1)
struct Params { const float* in[23]; float* out; unsigned char* ws; };

__device__ __forceinline__ unsigned f2bf(float f) { unsigned u = __builtin_bit_cast(unsigned, f); return (u + 0x7fffu + ((u >> 16) & 1u)) >> 16; }
__device__ __forceinline__ unsigned pk2(float lo, float hi) { return f2bf(lo) | (f2bf(hi) << 16); }
__device__ __forceinline__ float wave_sum(float v, int lane) {
#pragma unroll
    for (int o = 1; o < 64; o <<= 1) v += __builtin_bit_cast(float, __builtin_amdgcn_ds_bpermute((lane ^ o) << 2, __builtin_bit_cast(int, v)));
    return v;
}
__device__ __forceinline__ void transpose_item(const float* W, int ldw, int k0, int n0, bf16* WT, int ldt, int drow, LAS float* scr, int lane) {
    float wv[32];
#pragma unroll
    for (int i = 0; i < 32; ++i) wv[i] = W[(size_t)(k0 + 2 * i + (lane >> 5)) * ldw + n0 + (lane & 31)];
#pragma unroll
    for (int i = 0; i < 32; ++i) scr[(2 * i + (lane >> 5)) * 33 + (lane & 31)] = wv[i];
    asm volatile("s_waitcnt lgkmcnt(0)" ::: "memory");
    const int c = lane & 7;
#pragma unroll
    for (int j = 0; j < 4; ++j) { const int n = (lane >> 3) + 8 * j; const LAS float* s = scr + (8 * c) * 33 + n;
        v4u o; o.x = pk2(s[0 * 33], s[1 * 33]); o.y = pk2(s[2 * 33], s[3 * 33]); o.z = pk2(s[4 * 33], s[5 * 33]); o.w = pk2(s[6 * 33], s[7 * 33]);
        *(v4u*)(WT + (size_t)(drow + n) * ldt + k0 + 8 * c) = o; }
    asm volatile("s_waitcnt lgkmcnt(0)" ::: "memory");
}
__device__ __forceinline__ int t5_bucket(int rel) {
    const int n = rel < 0 ? -rel : rel;
    int b = n < 8 ? n : 8 + (n >= 15) + (n >= 27) + (n >= 50) + (n >= 91) + (n >= 166) + (n >= 305) + (n >= 559);
    return b + (rel > 0 ? 16 : 0);
}
__device__ __forceinline__ void convert_weights(const Params& P, int l, LAS unsigned char* lds, int gw, int ngw, int wave, int lane) {
    LAS float* scr = (LAS float*)(lds + wave * 16384);
    unsigned char* ws = P.ws;
    constexpr int I_UP = 16 * 88, I_DN = 44 * 32, I_IN = 16 * 240, I_BR = 8 * 32, I_O = 16 * 32;
    constexpr int NITEMS = 4 * I_UP + 2 * I_DN + I_IN + 3 * I_BR + I_O;
    for (int it = gw; it < NITEMS; it += ngw) {
        int r = it;
        if (r < 4 * I_UP) {
            const int which = r / I_UP; r -= which * I_UP; const int kb = r / 88, nb = r % 88, n0 = nb * 32;
            const float* W = (which == 0 ? P.in[2] : which == 1 ? P.in[3] : which == 2 ? P.in[19] : P.in[20]) + (size_t)l * DM * DFF;
            bf16* WT = (bf16*)(ws + (which < 2 ? W_13A : W_13B));
            const int drow = (n0 >> 7) * 256 + (which & 1) * 128 + (n0 & 127);
            transpose_item(W, DFF, kb * 64, n0, WT, DM, drow, scr, lane); continue; }
        r -= 4 * I_UP;
        if (r < 2 * I_DN) {
            const int which = r / I_DN; r -= which * I_DN; const int kb = r / 32, nb = r % 32;
            const float* W = (which == 0 ? P.in[4] : P.in[21]) + (size_t)l * DFF * DM;
            transpose_item(W, DM, kb * 64, nb * 32, (bf16*)(ws + (which == 0 ? W_2A : W_2B)), DFF, nb * 32, scr, lane); continue; }
        r -= 2 * I_DN;
        if (r < I_IN) {
            const int kb = r / 240, nb = r % 240, n0 = nb * 32; const float* W = P.in[6] + (size_t)l * DM * INC;
            const int seg = n0 >> 9, off = n0 & 511; bf16* WT; int drow;
            if (seg >= 9) { WT = (bf16*)(ws + W_G); drow = n0 - 4608; }
            else { const int br = seg / 3, kind = seg % 3;
                if (kind == 2) { WT = (bf16*)(ws + W_V); drow = br * 512 + off; }
                else { WT = (bf16*)(ws + W_QK); drow = kind * 1536 + br * 512 + off; } }
            transpose_item(W, INC, kb * 64, n0, WT, DM, drow, scr, lane); continue; }
        r -= I_IN;
        if (r < 3 * I_BR) {
            const int which = r / I_BR; r -= which * I_BR; const int kb = r / 32, nb = r % 32;
            const float* W = (which == 0 ? P.in[14] : which == 1 ? P.in[15] : P.in[16]) + (size_t)l * 512 * DM;
            transpose_item(W, DM, kb * 64, nb * 32, (bf16*)(ws + W_BR) + (size_t)which * DM * 512, 512, nb * 32, scr, lane); continue; }
        r -= 3 * I_BR;
        { const int kb = r / 32, nb = r % 32; const float* W = P.in[17] + (size_t)l * DM * DM;
          transpose_item(W, DM, kb * 64, nb * 32, (bf16*)(ws + W_O), DM, nb * 32, scr, lane); }
    }
}
__device__ __forceinline__ void build_luts(const Params& P, int gtid, int gthreads) {
    const float* t5 = P.in[13]; const float* rpb = P.in[12];
    float* la = (float*)(P.ws + WS_LUTA); float* lc = (float*)(P.ws + WS_LUTC); float* lb = (float*)(P.ws + WS_LUTB);
    for (int i = gtid; i < 4 * fa::LUT_N; i += gthreads) { const int h = i / fa::LUT_N, d = i % fa::LUT_N - fa::LUT_C; la[i] = t5[t5_bucket(d) * 12 + h] * LOG2E; }
    for (int i = gtid; i < 8 * fa::LUT_N; i += gthreads) { const int h = i / fa::LUT_N, d = i % fa::LUT_N - fa::LUT_C; const int n = d < 0 ? -d : d;
        const int mult = (n <= 64) + ((n & 3) == 0 && n <= 256) + ((n & 15) == 0 && n <= 1024);
        lc[i] = mult == 0 ? -3.0e38f : t5[t5_bucket(d) * 12 + 4 + h] * LOG2E + (mult == 1 ? 0.f : mult == 2 ? 1.0f : 1.5849625007211562f); }
    for (int i = gtid; i < 2 * 8 * 15 * 128; i += gthreads) { const int c = i & 127, rr = (i >> 7) % 15, lh = i / (15 * 128); const int rc = c - 48;
        lb[i] = (rc >= 0 && rc < 31) ? rpb[(size_t)(lh * 15 + rr) * 31 + rc] * LOG2E : 0.f; }
}
__device__ __forceinline__ void rms_row2(const float* xrow0, const float* xrow1, const float* g, bf16* xo0, bf16* xo1, float* fo0, float* fo1, int lane) {
    const f32x4* xr0 = (const f32x4*)xrow0 + lane; const f32x4* xr1 = (const f32x4*)xrow1 + lane; const f32x4* gr = (const f32x4*)g + lane;
    f32x4 v0[4], v1[4]; float s0 = 0.f, s1 = 0.f;
#pragma unroll
    for (int j = 0; j < 4; ++j) { v0[j] = xr0[64 * j]; v1[j] = xr1[64 * j]; }
#pragma unroll
    for (int j = 0; j < 4; ++j) { s0 += (v0[j].x * v0[j].x + v0[j].y * v0[j].y) + (v0[j].z * v0[j].z + v0[j].w * v0[j].w); s1 += (v1[j].x * v1[j].x + v1[j].y * v1[j].y) + (v1[j].z * v1[j].z + v1[j].w * v1[j].w); }
    const float r0 = 1.0f / sqrtf(wave_sum(s0, lane) * (1.f / DM) + EPS), r1 = 1.0f / sqrtf(wave_sum(s1, lane) * (1.f / DM) + EPS);
#pragma unroll
    for (int j = 0; j < 4; ++j) { const f32x4 gg = gr[64 * j]; const f32x4 y0 = v0[j] * r0 * gg, y1 = v1[j] * r1 * gg;
        if (xo0) { ((unsigned long long*)xo0)[lane + 64 * j] = (unsigned long long)pk2(y0.x, y0.y) | ((unsigned long long)pk2(y0.z, y0.w) << 32);
                   ((unsigned long long*)xo1)[lane + 64 * j] = (unsigned long long)pk2(y1.x, y1.y) | ((unsigned long long)pk2(y1.z, y1.w) << 32); }
        else { ((f32x4*)fo0)[lane + 64 * j] = y0; ((f32x4*)fo1)[lane + 64 * j] = y1; } }
}
__device__ __forceinline__ void diff_combine(const Params& P, int l, int gw, int ngw, int lane) {
    const float* lq1 = P.in[7] + l * 64; const float* lk1 = P.in[8] + l * 64; const float* lq2 = P.in[9] + l * 64; const float* lk2 = P.in[10] + l * 64;
    const float s1 = wave_sum(lq1[lane] * lk1[lane], lane), s2 = wave_sum(lq2[lane] * lk2[lane], lane);
    const float lam_init = 0.8f - 0.6f * expf(-0.3f * (float)l);
    const float lam = expf(s1) - expf(s2) + lam_init;
    const float* sg = P.in[11] + l * 128; const float g0 = sg[2 * lane] * (1.f - lam_init), g1 = sg[2 * lane + 1] * (1.f - lam_init);
    const unsigned* O1 = (const unsigned*)(P.ws + WS_O12); const unsigned* O2 = O1 + (size_t)MTOK * 256;
    bf16* QP = (bf16*)(P.ws + WS_QP);
    for (int it0 = gw; it0 < MTOK * 4; it0 += 4 * ngw) {
        unsigned a[4], b[4]; int itk[4];
#pragma unroll
        for (int k = 0; k < 4; ++k) { const int it = it0 + k * ngw; itk[k] = it < MTOK * 4 ? it : it0; const int row = itk[k] >> 2, h = itk[k] & 3;
            a[k] = O1[(size_t)row * 256 + h * 64 + lane]; b[k] = O2[(size_t)row * 256 + h * 64 + lane]; }
#pragma unroll
        for (int k = 0; k < 4; ++k) { const int row = itk[k] >> 2, h = itk[k] & 3;
            const float x0 = __builtin_bit_cast(float, a[k] << 16) - lam * __builtin_bit_cast(float, b[k] << 16), x1 = __builtin_bit_cast(float, a[k] & 0xffff0000u) - lam * __builtin_bit_cast(float, b[k] & 0xffff0000u);
            const float r = 1.0f / sqrtf(wave_sum(x0 * x0 + x1 * x1, lane) * (1.f / 128.f) + EPS);
            ((unsigned*)(QP + (size_t)row * 1536 + h * 128))[lane] = pk2(x0 * r * g0, x1 * r * g1); } }
}

__global__ void __launch_bounds__(NWAVES * 64, 2) fwd_megakernel(Params P) {
    extern __shared__ __attribute__((aligned(16))) unsigned char lds_raw[];
    cg::grid_group grid = cg::this_grid();
    LAS unsigned char* lds = (LAS unsigned char*)lds_raw;
    const int tid = threadIdx.x, lane = tid & 63, wave = __builtin_amdgcn_readfirstlane(tid >> 6);
    const int G = gridDim.x, bx = blockIdx.x;
    const int vcu = (G % 8 == 0) ? (bx % 8) * (G / 8) + bx / 8 : bx;
    const int gw = vcu * NWAVES + wave, ngw = G * NWAVES;
    unsigned char* ws = P.ws;
    bf16* XN = (bf16*)(ws + WS_XN); bf16* QP = (bf16*)(ws + WS_QP); bf16* KP = (bf16*)(ws + WS_KP); bf16* VT = (bf16*)(ws + WS_VT);
    bf16* O12 = (bf16*)(ws + WS_O12); bf16* MG = O12; bf16* U = (bf16*)(ws + WS_U); bf16* GT = (bf16*)(ws + WS_G);
    float* X = P.out;
    if (tid < 2) ((volatile LAS unsigned*)(lds + LDS_MISC))[tid] = 0u;
    __syncthreads();
    const XcdBarrier xbar = xcd_barrier_post((unsigned*)(ws + WS_BAR), (volatile LAS unsigned*)(lds + LDS_MISC));
    grid.sync();
    int bxo = bx;
#define GSYNC() xcd_barrier(xbar)
#define OPQ(v) asm volatile("" : "+s"(v) :: "memory")
#define OPQV(v) asm volatile("" : "+v"(v) :: "memory")
    int lno = 0;

#pragma unroll 1
    for (int l = 0; l < DEPTH; ++l) {
        lno = (int)threadIdx.x; OPQV(lno); lno &= 63; if (PH(0)) convert_weights(P, l, lds, gw, ngw, wave, lno);
        if (PH(0) && l == 0) build_luts(P, bx * NWAVES * 64 + wave * 64 + lno, G * NWAVES * 64);
        { const float* xs = (l == 0) ? P.in[0] : X;
          for (int m = gw; m < MTOK; m += 2 * ngw) { const int m1 = (m + ngw < MTOK) ? m + ngw : m; rms_row2(xs + (size_t)m * DM, xs + (size_t)m1 * DM, P.in[1] + l * DM, XN + (size_t)m * DM, XN + (size_t)m1 * DM, nullptr, nullptr, lno); } }
        GSYNC();
        if (PH(1)) { pg8::Gemm g{XN, (const bf16*)(ws + W_13A), MTOK, 2 * DFF, DM, DM, DM}; pg8::StaticOrder S; OPQ(bxo); S.init(MTOK, 2 * DFF, G, bxo);
          pg8::EpiSwiGLU E{U, DFF}; pg8::gemm_phase<pg8::EpiSwiGLU, pg8::StaticOrder, false, true>(lds, g, S, E); }
        GSYNC();
        if (PH(2)) { pg8::Gemm g{U, (const bf16*)(ws + W_2A), MTOK, DM, DFF, DFF, DFF}; pg8::StaticOrder S; OPQ(bxo); S.init(MTOK, DM, G, bxo);
          pg8::EpiResid E{(l == 0) ? P.in[0] : X, X, DM, 0.5f}; pg8::gemm_phase<pg8::EpiResid, pg8::StaticOrder, true, true>(lds, g, S, E); }
        GSYNC();
        if (STOP_AFTER == 1) break;
        lno = (int)threadIdx.x; OPQV(lno); lno &= 63; for (int m = gw; m < MTOK; m += 2 * ngw) { const int m1 = (m + ngw < MTOK) ? m + ngw : m; rms_row2(X + (size_t)m * DM, X + (size_t)m1 * DM, P.in[5] + l * DM, XN + (size_t)m * DM, XN + (size_t)m1 * DM, nullptr, nullptr, lno); }
        GSYNC();
        if (PH(3)) { pg8::Gemm g{XN, (const bf16*)(ws + W_QK), MTOK, 3072, DM, DM, DM}; pg8::StaticOrder S; OPQ(bxo); S.init(MTOK, 3072, G, bxo);
          pg8::EpiBf16<0> E{QP, 1536, 1536, (size_t)MTOK * 1536, QSCALE}; pg8::gemm_phase<pg8::EpiBf16<0>, pg8::StaticOrder, true, true>(lds, g, S, E); }
        if (PH(3)) { pg8::Gemm g{(const bf16*)(ws + W_V), XN, 1536, MTOK, DM, DM, DM}; pg8::StaticOrder S; OPQ(bxo); S.init(1536, MTOK, G, bxo);
          pg8::EpiBf16<0> E{VT, MTOK, 0, 0, 1.f}; pg8::gemm_phase<pg8::EpiBf16<0>, pg8::StaticOrder, true, true>(lds, g, S, E); }
        GSYNC();
        int prev_h = -1;
        if (PH(4)) for (int un = vcu; un < 1024; un += G) { const int combo = (un & 255) >> 3, qb = (un & 7) + 8 * (un >> 8);
            const int b = combo >> 3, h = (combo >> 1) & 3, m = combo & 1;
            fa::Unit u; u.load_lut = (h != prev_h); prev_h = h; u.Q = QP + h * 128 + m * 64; u.K = KP + h * 128 + m * 64; u.VT = VT + (size_t)(h * 128) * MTOK; u.O = O12 + (size_t)m * MTOK * 512 + h * 128;
            u.lut = (const float*)(ws + WS_LUTA) + h * fa::LUT_N; u.ldq = 1536; u.ldk = 1536; u.ldo = 512; u.tok0 = b * SEQ; u.q0 = qb * 256; u.t_lo = 0; u.t_hi = SEQ / 64;
            fa::attn_unit_a(lds, u); }
        prev_h = -1;
        if (PH(5)) for (int un = vcu; un < 1024; un += G) { const int combo = (un & 255) >> 3, qb = (un & 7) + 8 * (un >> 8);
            const int b = combo >> 3, h = combo & 7;
            fa::Unit u; u.load_lut = (h != prev_h); prev_h = h; u.Q = QP + 1024 + h * 64; u.K = KP + 1024 + h * 64; u.VT = VT + (size_t)(1024 + h * 64) * MTOK; u.O = QP + 1024 + h * 64;
            u.lut = (const float*)(ws + WS_LUTC) + h * fa::LUT_N; u.ldq = 1536; u.ldk = 1536; u.ldo = 1536; u.tok0 = b * SEQ; u.q0 = qb * 256;
            const int lo = qb * 4 - 16, hi2 = qb * 4 + 20; u.t_lo = lo < 0 ? 0 : lo; u.t_hi = hi2 > SEQ / 64 ? SEQ / 64 : hi2;
            fa::attn_unit<2>(lds, u); }
        prev_h = -1;
        if (PH(6)) for (int un = vcu; un < 1024; un += G) { const int combo = (un & 255) >> 3, qb = (un & 7) + 8 * (un >> 8);
            const int b = combo >> 3, h = combo & 7;
            fa::Unit u; u.load_lut = (h != prev_h); prev_h = h; u.Q = QP + 512 + h * 64; u.K = KP + 512 + h * 64; u.VT = VT + (size_t)(512 + h * 64) * MTOK; u.O = QP + 512 + h * 64;
            u.lut = (const float*)(ws + WS_LUTB) + (size_t)(l * 8 + h) * 15 * 128; u.ldq = 1536; u.ldk = 1536; u.ldo = 1536; u.tok0 = b * SEQ; u.q0 = qb * 256;
            const int g0 = qb * 4, g3 = qb * 4 + 3; const int r0 = g0 - 4 < 0 ? 0 : (g0 - 4 > 120 ? 120 : g0 - 4), r3 = g3 - 4 < 0 ? 0 : (g3 - 4 > 120 ? 120 : g3 - 4);
            u.t_lo = r0; u.t_hi = r3 + 8;
            fa::attn_unit<1>(lds, u); }
        GSYNC();
        lno = (int)threadIdx.x; OPQV(lno); lno &= 63; if (PH(7)) diff_combine(P, l, gw, ngw, lno);
        if (PH(8)) { pg8::Gemm g{XN, (const bf16*)(ws + W_G), MTOK, 3072, DM, DM, DM}; pg8::StaticOrder S; OPQ(bxo); S.init(MTOK, 3072, G, bxo);
          pg8::EpiBf16<GACT> E{GT, DM, DM, (size_t)MTOK * DM, 1.f}; pg8::gemm_phase<pg8::EpiBf16<GACT>, pg8::StaticOrder, true, true>(lds, g, S, E); }
        GSYNC();
#pragma unroll 1
        for (int i = 0; i < BR_N * PH(9); ++i) { pg8::Gemm g{QP + i * 512, (const bf16*)(ws + W_BR) + (size_t)i * DM * 512, MTOK, DM, 512, 1536, 512}; pg8::StaticOrder S; OPQ(bxo); S.init(MTOK, DM, G, bxo);
            pg8::EpiGate E{GT + (size_t)i * MTOK * DM, MG, DM, i == 0}; pg8::gemm_phase<pg8::EpiGate, pg8::StaticOrder, true, true>(lds, g, S, E);
            __builtin_amdgcn_fence(__ATOMIC_ACQUIRE, "agent"); asm volatile("s_waitcnt vmcnt(0)" ::: "memory"); }
        GSYNC();
        if (PH(10)) { pg8::Gemm g{MG, (const bf16*)(ws + W_O), MTOK, DM, DM, DM, DM}; pg8::StaticOrder S; OPQ(bxo); S.init(MTOK, DM, G, bxo);
          pg8::EpiResid E{X, X, DM, 1.0f}; pg8::gemm_phase<pg8::EpiResid, pg8::StaticOrder, true, true>(lds, g, S, E); }
        GSYNC();
        if (STOP_AFTER == 2) break;
        lno = (int)threadIdx.x; OPQV(lno); lno &= 63; for (int m = gw; m < MTOK; m += 2 * ngw) { const int m1 = (m + ngw < MTOK) ? m + ngw : m; rms_row2(X + (size_t)m * DM, X + (size_t)m1 * DM, P.in[18] + l * DM, XN + (size_t)m * DM, XN + (size_t)m1 * DM, nullptr, nullptr, lno); }
        GSYNC();
        if (PH(11)) { pg8::Gemm g{XN, (const bf16*)(ws + W_13B), MTOK, 2 * DFF, DM, DM, DM}; pg8::StaticOrder S; OPQ(bxo); S.init(MTOK, 2 * DFF, G, bxo);
          pg8::EpiSwiGLU E{U, DFF}; pg8::gemm_phase<pg8::EpiSwiGLU, pg8::StaticOrder, false, true>(lds, g, S, E); }
        GSYNC();
        if (PH(12)) { pg8::Gemm g{U, (const bf16*)(ws + W_2B), MTOK, DM, DFF, DFF, DFF}; pg8::StaticOrder S; OPQ(bxo); S.init(MTOK, DM, G, bxo);
          pg8::EpiResid E{X, X, DM, 0.5f}; pg8::gemm_phase<pg8::EpiResid, pg8::StaticOrder, true, true>(lds, g, S, E); }
        GSYNC();
        if (STOP_AFTER == 3) break;
    }
    lno = (int)threadIdx.x; OPQV(lno); lno &= 63; for (int m = gw; m < MTOK; m += 2 * ngw) { const int m1 = (m + ngw < MTOK) ? m + ngw : m; rms_row2(X + (size_t)m * DM, X + (size_t)m1 * DM, P.in[22], nullptr, nullptr, X + (size_t)m * DM, X + (size_t)m1 * DM, lno); }
}

extern "C" void kernel_launch(void* const* d_in, const int* in_sizes, int n_in, void* d_out, int out_size, void* d_ws, size_t ws_size, hipStream_t stream) {
    static int grid = 0;
    if (grid == 0) {
        if (n_in != 23 || out_size != MTOK * DM || ws_size < WS_END) { fprintf(stderr, "kernel_launch: unexpected shapes (n_in %d out %d ws %zu)\n", n_in, out_size, ws_size); grid = -1; return; }
        int dev = 0, cus = 0, per_cu = 0;
        hipGetDevice(&dev); hipDeviceGetAttribute(&cus, hipDeviceAttributeMultiprocessorCount, dev);
        if (hipFuncSetAttribute((const void*)fwd_megakernel, hipFuncAttributeMaxDynamicSharedMemorySize, LDS_BYTES) != hipSuccess) { fprintf(stderr, "kernel_launch: hipFuncSetAttribute failed\n"); grid = -1; return; }
        if (hipOccupancyMaxActiveBlocksPerMultiprocessor(&per_cu, (const void*)fwd_megakernel, NWAVES * 64, LDS_BYTES) != hipSuccess || per_cu < 1) { fprintf(stderr, "kernel_launch: occupancy query says %d\n", per_cu); per_cu = 1; }
        (void)hipGetLastError();
        grid = cus * 1;
    }
    if (grid < 0) return;
    if (hipMemsetAsync((char*)d_ws + WS_BAR, 0, BAR_BYTES, stream) != hipSuccess) { fprintf(stderr, "kernel_launch: memset of the barrier words failed\n"); return; }
    Params p{};
    for (int i = 0; i < 23; ++i) p.in[i] = (const float*)d_in[i];
    p.out = (float*)d_out; p.ws = (unsigned char*)d_ws;
    void* args[] = {&p};
    hipError_t e = hipLaunchCooperativeKernel((const void*)fwd_megakernel, dim3(grid), dim3(NWAVES * 64), args, LDS_BYTES, stream);
    if (e != hipSuccess) fprintf(stderr, "cooperative launch failed: %s (grid %d)\n", hipGetErrorString(e), grid);
}
```

```cpp
#include <hip/hip_runtime.h>
#include <hip/hip_cooperative_groups.h>
#include <cstdio>
#include <cstdint>
#include <cmath>
namespace cg = cooperative_groups;
namespace pg8 {
#define PG8_LAS __attribute__((address_space(3)))
typedef unsigned short bf16_t;
typedef short bf16x8 __attribute__((ext_vector_type(8)));
typedef float f32x4 __attribute__((ext_vector_type(4)));
typedef unsigned u32x4 __attribute__((ext_vector_type(4)));
constexpr int BM = 256, BK = 64, HALF = 128, HTB = HALF * BK * 2  , STAGE_BYTES = 8 * HTB, NXCD = 8, WGM = 8;

__host__ __device__ __forceinline__ int lds_byte(int r, int c) { const int st = (r >> 4) * 2 + (c >> 5), rr = r & 15, cc = c & 31, ob = rr * 64 + cc * 2; return st * 1024 + (ob ^ (((ob >> 9) & 1) << 5)); }
__host__ __device__ __forceinline__ void stage_rc(int b, int& R, int& C) { const int st = b / 1024, sb = b % 1024, swz = sb ^ (((sb >> 9) & 1) << 5); R = (st >> 1) * 16 + swz / 64; C = (st & 1) * 32 + (swz % 64) / 2; }
__host__ __device__ __forceinline__ int perm32(int rho) { const int n = rho >> 4, i = rho & 15; return 8 * (i >> 2) + 4 * n + (i & 3); }

struct Unit { int pm, pn; };
struct Gemm { const bf16_t* A; const bf16_t* Bt; int M, N, K, lda, ldb; };

struct StaticOrder {
    int nM, nN, nwg, G, c;
    __host__ __device__ void init(int M, int N, int G_, int c_) { nM = M / BM; nN = N / BM; nwg = nM * nN; G = G_; c = c_; }
    __host__ __device__ bool next(int i, Unit& u) const {
        const long L = (long)i * G + c; if (L >= nwg) return false;
        int wgid = (int)L; { const int q = nwg / NXCD, r = nwg % NXCD, xcd = wgid % NXCD, off = wgid / NXCD; wgid = (xcd < r ? xcd * (q + 1) : r * (q + 1) + (xcd - r) * q) + off; }
        const int nig = WGM * nN, gid = wgid / nig, fm = gid * WGM, gsz = (nM - fm) < WGM ? (nM - fm) : WGM;
        u.pm = fm + ((wgid % nig) % gsz); u.pn = (wgid % nig) / gsz; return true;
    }
    __device__ __forceinline__ void a_ready(const Unit&) const {}
    __device__ __forceinline__ void done(const Unit&) const {}
};

typedef float f32x2_t __attribute__((ext_vector_type(2))); typedef __bf16 bf16x2_t __attribute__((ext_vector_type(2)));
__device__ __forceinline__ unsigned cvt_pk_bf16(float lo, float hi) { f32x2_t v = {lo, hi}; bf16x2_t b = __builtin_convertvector(v, bf16x2_t); return __builtin_bit_cast(unsigned, b); }
__device__ __forceinline__ float bf_lo(unsigned w) { return __builtin_bit_cast(float, w << 16); }
__device__ __forceinline__ float bf_hi(unsigned w) { return __builtin_bit_cast(float, w & 0xffff0000u); }
__device__ __forceinline__ float sigmoid_f(float v) { return __builtin_amdgcn_rcpf(1.0f + __builtin_amdgcn_exp2f(-1.4426950408889634f * v)); }

template <int ACT> struct EpiBf16 {
    static constexpr bool PERM = true, AFTER_DRAIN = false;
    bf16_t* O; int ldc; int split_cols; size_t split_stride; float scale0;
    __device__ __forceinline__ void operator()(const f32x4 (&acc)[2][2][4][2], const Unit& u, int wr, int wc, int fr, int fq) const {
        const int row0 = u.pm * BM + wr * 64 + fr; int colt = u.pn * BM; bf16_t* base = O;
        float sc = 1.f; if (split_cols) { const int t = colt / split_cols; base += (size_t)t * split_stride; colt -= t * split_cols; if (t == 0) sc = scale0; }
        const int col0 = colt + wc * 32 + 8 * fq;
#pragma unroll
        for (int ai = 0; ai < 2; ++ai)
#pragma unroll
            for (int m = 0; m < 4; ++m) { bf16_t* rowp = base + (size_t)(row0 + ai * HALF + m * 16) * ldc + col0;
#pragma unroll
                for (int bj = 0; bj < 2; ++bj) { f32x4 v0 = acc[ai][bj][m][0], v1 = acc[ai][bj][m][1];
                    if (ACT == 2) { v0 = (f32x4){sigmoid_f(v0[0]), sigmoid_f(v0[1]), sigmoid_f(v0[2]), sigmoid_f(v0[3])}; v1 = (f32x4){sigmoid_f(v1[0]), sigmoid_f(v1[1]), sigmoid_f(v1[2]), sigmoid_f(v1[3])}; }
                    v0 = v0 * sc; v1 = v1 * sc; u32x4 w; w.x = cvt_pk_bf16(v0[0], v0[1]); w.y = cvt_pk_bf16(v0[2], v0[3]); w.z = cvt_pk_bf16(v1[0], v1[1]); w.w = cvt_pk_bf16(v1[2], v1[3]);
                    *(u32x4*)(rowp + bj * HALF) = w; } asm volatile("" ::: "memory"); }
    }
};
struct EpiSwiGLU {
    static constexpr bool PERM = true, AFTER_DRAIN = false;
    bf16_t* U; int ldc;
    __device__ __forceinline__ void operator()(const f32x4 (&acc)[2][2][4][2], const Unit& u, int wr, int wc, int fr, int fq) const {
        const int row0 = u.pm * BM + wr * 64 + fr; const int col0 = u.pn * HALF + wc * 32 + 8 * fq;
#pragma unroll
        for (int ai = 0; ai < 2; ++ai)
#pragma unroll
            for (int m = 0; m < 4; ++m) { bf16_t* rowp = U + (size_t)(row0 + ai * HALF + m * 16) * ldc + col0;
                float r[8];
#pragma unroll
                for (int n = 0; n < 2; ++n)
#pragma unroll
                    for (int j = 0; j < 4; ++j) { const float a = acc[ai][0][m][n][j], b = acc[ai][1][m][n][j]; r[n * 4 + j] = a * sigmoid_f(a) * b; }
                u32x4 w; w.x = cvt_pk_bf16(r[0], r[1]); w.y = cvt_pk_bf16(r[2], r[3]); w.z = cvt_pk_bf16(r[4], r[5]); w.w = cvt_pk_bf16(r[6], r[7]);
                *(u32x4*)rowp = w; asm volatile("" ::: "memory"); }
    }
};
struct EpiResid {
    static constexpr bool PERM = false, AFTER_DRAIN = false;
    const float* xin; float* xout; int ldc; float s;
    __device__ __forceinline__ void operator()(const f32x4 (&acc)[2][2][4][2], const Unit& u, int wr, int wc, int fr, int fq) const {
        const int col0 = u.pn * BM + wc * 32 + 4 * fq;
#pragma unroll
        for (int ai = 0; ai < 2; ++ai) {
            f32x4 bs[4][2][2];
#pragma unroll
            for (int m = 0; m < 4; ++m) { const size_t off = (size_t)(u.pm * BM + ai * HALF + wr * 64 + m * 16 + fr) * ldc + col0;
#pragma unroll
                for (int bj = 0; bj < 2; ++bj)
#pragma unroll
                    for (int n = 0; n < 2; ++n) bs[m][bj][n] = *(const f32x4*)(xin + off + bj * HALF + n * 16); }
            asm volatile("" ::: "memory");
#pragma unroll
            for (int m = 0; m < 4; ++m) { const size_t off = (size_t)(u.pm * BM + ai * HALF + wr * 64 + m * 16 + fr) * ldc + col0;
#pragma unroll
                for (int bj = 0; bj < 2; ++bj)
#pragma unroll
                    for (int n = 0; n < 2; ++n) *(f32x4*)(xout + off + bj * HALF + n * 16) = bs[m][bj][n] + acc[ai][bj][m][n] * s; }
            asm volatile("" ::: "memory"); }
    }
};
struct EpiGate {
    static constexpr bool PERM = true, AFTER_DRAIN = false;
    const bf16_t* G; bf16_t* MG; int ldc; int first;
    __device__ __forceinline__ void operator()(const f32x4 (&acc)[2][2][4][2], const Unit& u, int wr, int wc, int fr, int fq) const {
        const int row0 = u.pm * BM + wr * 64 + fr; const int col0 = u.pn * BM + wc * 32 + 8 * fq;
#pragma unroll
        for (int ai = 0; ai < 2; ++ai) {
            u32x4 g[4][2], p[4][2];
#pragma unroll
            for (int m = 0; m < 4; ++m) { const size_t off = (size_t)(row0 + ai * HALF + m * 16) * ldc + col0;
#pragma unroll
                for (int bj = 0; bj < 2; ++bj) { g[m][bj] = *(const u32x4*)(G + off + bj * HALF); if (!first) p[m][bj] = *(const u32x4*)(MG + off + bj * HALF); else p[m][bj] = (u32x4){0u, 0u, 0u, 0u}; } }
            asm volatile("" ::: "memory");
#pragma unroll
            for (int m = 0; m < 4; ++m) { const size_t off = (size_t)(row0 + ai * HALF + m * 16) * ldc + col0;
#pragma unroll
                for (int bj = 0; bj < 2; ++bj) { const u32x4 gg = g[m][bj], pp = p[m][bj]; const f32x4 v0 = acc[ai][bj][m][0], v1 = acc[ai][bj][m][1];
                    u32x4 w;
                    w.x = cvt_pk_bf16(bf_lo(gg.x) * v0[0] + bf_lo(pp.x), bf_hi(gg.x) * v0[1] + bf_hi(pp.x)); w.y = cvt_pk_bf16(bf_lo(gg.y) * v0[2] + bf_lo(pp.y), bf_hi(gg.y) * v0[3] + bf_hi(pp.y));
                    w.z = cvt_pk_bf16(bf_lo(gg.z) * v1[0] + bf_lo(pp.z), bf_hi(gg.z) * v1[1] + bf_hi(pp.z)); w.w = cvt_pk_bf16(bf_lo(gg.w) * v1[2] + bf_lo(pp.w), bf_hi(gg.w) * v1[3] + bf_hi(pp.w));
                    *(u32x4*)(MG + off + bj * HALF) = w; } }
            asm volatile("" ::: "memory"); }
    }
};
template <class Epi, class Sched, bool ALIGN_EPI = false, bool SP2 = false>
__device__ __forceinline__ void gemm_phase(PG8_LAS unsigned char* lds, const Gemm g, const Sched& S, const Epi& E) {
    int tid_ = threadIdx.x; asm volatile("" : "+v"(tid_));
    const int tid = tid_, wid = __builtin_amdgcn_readfirstlane(tid >> 6), lane = tid & 63, wr = wid >> 2, wc = wid & 3, fr = lane & 15, fq = lane >> 4;
    const int K = g.K, nt = K / BK;
    unsigned voffA[2], voffB[2];
#pragma unroll
    for (int i = 0; i < 2; ++i) { int R, C; stage_rc(tid * 16 + i * 8192, R, C); const int Rb = Epi::PERM ? ((R & ~31) + perm32(R & 31)) : R;
        voffA[i] = (unsigned)(R * g.lda + C) * 2u; voffB[i] = (unsigned)(Rb * g.ldb + C) * 2u; }
    const size_t kstep = (size_t)(BK * 2);
    const size_t hstepA = (size_t)HALF * g.lda * 2, hstepB = (size_t)HALF * g.ldb * 2;
    const size_t tstepA = 2 * hstepA, tstepB = 2 * hstepB;
    const unsigned ldsw = (unsigned)wid * 1024u;
    const int aoff = lds_byte(wr * 64 + fr, fq * 8), boff = lds_byte(wc * 32 + fr, fq * 8);
#define PG8_SA(b, h) (((b) * 2 + (h)) * HTB)
#define PG8_SB(b, h) ((4 + (b) * 2 + (h)) * HTB)
#define PG8_STAGE(bufoff, gbase, voff) do { _Pragma("unroll") for (int _i = 0; _i < 2; ++_i) \
        __builtin_amdgcn_global_load_lds((const unsigned*)((const char*)(gbase) + (voff)[_i]), (PG8_LAS unsigned*)(lds + (bufoff) + ldsw + _i * 8192), 16, 0, 0); } while (0)
#define PG8_LDA(dst, b, h) do { _Pragma("unroll") for (int m = 0; m < 4; ++m) _Pragma("unroll") for (int k = 0; k < 2; ++k) dst[m][k] = *(const PG8_LAS bf16x8*)(lds + PG8_SA(b, h) + aoff + m * 2048 + k * 1024); } while (0)
#define PG8_LDB(dst, b, h) do { _Pragma("unroll") for (int n = 0; n < 2; ++n) _Pragma("unroll") for (int k = 0; k < 2; ++k) dst[n][k] = *(const PG8_LAS bf16x8*)(lds + PG8_SB(b, h) + boff + n * 2048 + k * 1024); } while (0)
#define PG8_MMA(ai, bj, At, Bt) do { __builtin_amdgcn_s_setprio(1); _Pragma("unroll") for (int m = 0; m < 4; ++m) _Pragma("unroll") for (int n = 0; n < 2; ++n) _Pragma("unroll") for (int k = 0; k < 2; ++k) \
        acc[ai][bj][m][n] = __builtin_amdgcn_mfma_f32_16x16x32_bf16(Bt[n][k], At[m][k], acc[ai][bj][m][n], 0, 0, 0); __builtin_amdgcn_s_setprio(0); } while (0)
#define PG8_WAIT_V(n) asm volatile("s_waitcnt vmcnt(" #n ")" ::: "memory")
#define PG8_WAIT_L(n) asm volatile("s_waitcnt lgkmcnt(" #n ")" ::: "memory")
#define PG8_BAR __builtin_amdgcn_s_barrier()
#define PG8_SCHED __builtin_amdgcn_sched_barrier(0)
    Unit cur, nxt; int ui = 0;
    if (!S.next(0, cur)) return;
    f32x4 acc[2][2][4][2];
#pragma unroll
    for (int a = 0; a < 2; ++a)
#pragma unroll
        for (int b = 0; b < 2; ++b)
#pragma unroll
            for (int m = 0; m < 4; ++m)
#pragma unroll
                for (int n = 0; n < 2; ++n) acc[a][b][m][n] = (f32x4){0.f, 0.f, 0.f, 0.f};
    bf16x8 At[4][2], B0[2][2], B1[2][2];
    const char* cA = (const char*)g.A + (size_t)cur.pm * tstepA; const char* cB = (const char*)g.Bt + (size_t)cur.pn * tstepB;
    S.a_ready(cur);
    if constexpr (SP2) {
        PG8_STAGE(PG8_SB(0, 0), cB, voffB); PG8_STAGE(PG8_SB(0, 1), cB + hstepB, voffB); PG8_STAGE(PG8_SA(0, 0), cA, voffA); PG8_STAGE(PG8_SA(0, 1), cA + hstepA, voffA);
        if (wr == 1) PG8_BAR;
        PG8_WAIT_V(2); PG8_BAR;
        PG8_STAGE(PG8_SB(1, 0), cB + kstep, voffB); PG8_STAGE(PG8_SA(1, 0), cA + kstep, voffA); PG8_STAGE(PG8_SB(1, 1), cB + hstepB + kstep, voffB);
        PG8_WAIT_V(6); PG8_BAR;
    } else {
        PG8_STAGE(PG8_SB(0, 0), cB, voffB); PG8_STAGE(PG8_SA(0, 0), cA, voffA); PG8_STAGE(PG8_SB(0, 1), cB + hstepB, voffB); PG8_STAGE(PG8_SA(0, 1), cA + hstepA, voffA);
        if (wr == 1) PG8_BAR;
        PG8_WAIT_V(4); PG8_BAR;
        PG8_STAGE(PG8_SB(1, 0), cB + kstep, voffB); PG8_STAGE(PG8_SA(1, 0), cA + kstep, voffA); PG8_STAGE(PG8_SB(1, 1), cB + hstepB + kstep, voffB);
        PG8_WAIT_V(6); PG8_BAR;
    }
    for (;;) {
        const bool has_next = S.next(ui + 1, nxt);
        const char* nA = has_next ? (const char*)g.A + (size_t)nxt.pm * tstepA : cA; const char* nB = has_next ? (const char*)g.Bt + (size_t)nxt.pn * tstepB : cB;
        for (int t = 0; t < nt; t += 2) {
            const bool last = (t == nt - 2);
            const char* a1 = cA + (size_t)(t + 1) * kstep;
            const char* a2 = last ? nA : cA + (size_t)(t + 2) * kstep; const char* b2 = last ? nB : cB + (size_t)(t + 2) * kstep;
            const char* a3 = a2 + kstep; const char* b3 = b2 + kstep;
            if (last && has_next) S.a_ready(nxt);
            if constexpr (SP2) {
            PG8_LDB(B0, 0, 0); PG8_LDB(B1, 0, 1); PG8_SCHED; PG8_LDA(At, 0, 0); PG8_STAGE(PG8_SA(1, 1), a1 + hstepA, voffA);
            PG8_WAIT_V(8); PG8_WAIT_L(0); PG8_BAR; PG8_MMA(0, 0, At, B0); PG8_MMA(0, 1, At, B1); PG8_BAR; PG8_SCHED;
            PG8_LDA(At, 0, 1); PG8_STAGE(PG8_SB(0, 0), b2, voffB); PG8_STAGE(PG8_SB(0, 1), b2 + hstepB, voffB); PG8_STAGE(PG8_SA(0, 0), a2, voffA);
            PG8_WAIT_V(8); PG8_WAIT_L(0); PG8_BAR; PG8_MMA(1, 0, At, B0); PG8_MMA(1, 1, At, B1); PG8_BAR; PG8_SCHED;
            PG8_LDB(B0, 1, 0); PG8_LDB(B1, 1, 1); PG8_SCHED; PG8_LDA(At, 1, 0); PG8_STAGE(PG8_SA(0, 1), a2 + hstepA, voffA);
            PG8_WAIT_V(8); PG8_WAIT_L(0); PG8_BAR; PG8_MMA(0, 0, At, B0); PG8_MMA(0, 1, At, B1); PG8_BAR; PG8_SCHED;
            PG8_LDA(At, 1, 1); PG8_STAGE(PG8_SB(1, 0), b3, voffB); PG8_STAGE(PG8_SB(1, 1), b3 + hstepB, voffB); PG8_STAGE(PG8_SA(1, 0), a3, voffA);
            PG8_WAIT_V(8); PG8_WAIT_L(0); PG8_BAR; PG8_MMA(1, 0, At, B0); PG8_MMA(1, 1, At, B1); PG8_BAR; PG8_SCHED;
            } else {
            PG8_LDB(B0, 0, 0); PG8_SCHED; PG8_LDA(At, 0, 0); PG8_STAGE(PG8_SA(1, 1), a1 + hstepA, voffA);
            PG8_WAIT_L(8); PG8_BAR; PG8_WAIT_L(0); PG8_MMA(0, 0, At, B0); PG8_BAR; PG8_SCHED;
            PG8_LDB(B1, 0, 1); PG8_STAGE(PG8_SB(0, 0), b2, voffB);
            PG8_BAR; PG8_WAIT_L(0); PG8_MMA(0, 1, At, B1); PG8_BAR;
            PG8_LDA(At, 0, 1); PG8_STAGE(PG8_SA(0, 0), a2, voffA);
            PG8_BAR; PG8_WAIT_L(0); PG8_MMA(1, 0, At, B0); PG8_BAR; PG8_SCHED;
            PG8_STAGE(PG8_SB(0, 1), b2 + hstepB, voffB);
            PG8_WAIT_V(6); PG8_BAR; PG8_MMA(1, 1, At, B1); PG8_BAR;
            PG8_LDB(B0, 1, 0); PG8_SCHED; PG8_LDA(At, 1, 0); PG8_STAGE(PG8_SA(0, 1), a2 + hstepA, voffA);
            PG8_WAIT_L(8); PG8_BAR; PG8_WAIT_L(0); PG8_MMA(0, 0, At, B0); PG8_BAR; PG8_SCHED;
            PG8_LDB(B1, 1, 1); PG8_STAGE(PG8_SB(1, 0), b3, voffB);
            PG8_BAR; PG8_WAIT_L(0); PG8_MMA(0, 1, At, B1); PG8_BAR;
            PG8_LDA(At, 1, 1); PG8_STAGE(PG8_SA(1, 0), a3, voffA);
            PG8_BAR; PG8_WAIT_L(0); PG8_MMA(1, 0, At, B0); PG8_BAR; PG8_SCHED;
            PG8_STAGE(PG8_SB(1, 1), b3 + hstepB, voffB);
            PG8_WAIT_V(6); PG8_BAR; PG8_MMA(1, 1, At, B1); PG8_BAR;
            }
        }
        if constexpr (ALIGN_EPI) { if (wr == 0) PG8_BAR; }
        if constexpr (!Epi::AFTER_DRAIN) { E(acc, cur, wr, wc, fr, fq); S.done(cur); }
        if (!has_next) break;
#pragma unroll
        for (int a = 0; a < 2; ++a)
#pragma unroll
            for (int b = 0; b < 2; ++b)
#pragma unroll
                for (int m = 0; m < 4; ++m)
#pragma unroll
                    for (int n = 0; n < 2; ++n) acc[a][b][m][n] = (f32x4){0.f, 0.f, 0.f, 0.f};
        cur = nxt; cA = nA; cB = nB; ++ui;
        if constexpr (ALIGN_EPI) { if (wr == 1) PG8_BAR; }
    }
    PG8_WAIT_V(0);
    if constexpr (!ALIGN_EPI) { if (wr == 0) PG8_BAR; }
    PG8_BAR;
    if constexpr (Epi::AFTER_DRAIN) { E.fused(acc, cur, wr, wc, fr, fq, lds, wid, lane); S.done(cur); }
#undef PG8_SA
#undef PG8_SB
#undef PG8_STAGE
#undef PG8_LDA
#undef PG8_LDB
#undef PG8_MMA
#undef PG8_WAIT_V
#undef PG8_WAIT_L
#undef PG8_BAR
#undef PG8_SCHED
}
}
namespace fa {
typedef unsigned short bf16_t;
typedef short bf16x8 __attribute__((ext_vector_type(8)));
typedef float f32x16 __attribute__((ext_vector_type(16)));
typedef unsigned u32x4 __attribute__((ext_vector_type(4)));
typedef unsigned u32x2 __attribute__((ext_vector_type(2)));
typedef float f32x2_t __attribute__((ext_vector_type(2))); typedef __bf16 bf16x2_t __attribute__((ext_vector_type(2)));
#define FLAS __attribute__((address_space(3)))
#define FA_SB() __builtin_amdgcn_sched_barrier(0)
constexpr int SEQ = 8192, MTOK = 32768;
constexpr int LUT_N = 2688, LUT_C = 1344;
constexpr int KBUF = 8192, VPITCH = 144, VBUF = 128 * VPITCH;
constexpr int L_K = 0, L_V = 2 * KBUF, L_LUT = L_V + 2 * VBUF, L_END = L_LUT + LUT_N * 4;
__device__ __forceinline__ unsigned cvtpk(float lo, float hi) { f32x2_t v = {lo, hi}; bf16x2_t b = __builtin_convertvector(v, bf16x2_t); return __builtin_bit_cast(unsigned, b); }
__device__ __forceinline__ void xswap(unsigned& a, unsigned& b) { asm volatile("s_nop 1\n\tv_permlane32_swap_b32 %0, %1\n\ts_nop 1" : "+v"(a), "+v"(b)); }
__device__ __forceinline__ float fadd_s(float a, float b) { float r; asm("v_add_f32_e32 %0, %1, %2" : "=v"(r) : "v"(a), "v"(b)); return r; }
__device__ __forceinline__ float xhalf_max(float m) { unsigned a = __builtin_bit_cast(unsigned, m), b = a; xswap(a, b); return __builtin_fmaxf(__builtin_bit_cast(float, a), __builtin_bit_cast(float, b)); }
__device__ __forceinline__ float xhalf_sum(float m) { unsigned a = __builtin_bit_cast(unsigned, m), b = a; xswap(a, b); return __builtin_bit_cast(float, a) + __builtin_bit_cast(float, b); }

struct Unit {
    const bf16_t* Q;
    const bf16_t* K;
    const bf16_t* VT;
    bf16_t* O;
    const float* lut;
    int ldq, ldk, ldo;
    int tok0;
    int q0;
    int t_lo, t_hi;
    int load_lut;
};

template <int MODE> __device__ __forceinline__ void attn_unit(FLAS unsigned char* lds, const Unit u) {
    constexpr int DV = (MODE == 0) ? 128 : 64, NDB = DV / 32, NVR = DV / 64;
    int tid_ = threadIdx.x; asm volatile("" : "+v"(tid_));
    const int tid = tid_, lane = tid & 63, r32 = lane & 31, hi = lane >> 5; const int wid = __builtin_amdgcn_readfirstlane(tid >> 6);
    const int q0w = u.q0 + 32 * wid;
    const int q = q0w + r32;
    if (u.load_lut) { FLAS float* L = (FLAS float*)(lds + L_LUT); const int n = (MODE == 1) ? 15 * 128 : LUT_N; for (int i = tid; i < n; i += 512) L[i] = u.lut[i]; }
    bf16x8 qr[4];
    { const bf16_t* qp = u.Q + (size_t)(u.tok0 + q) * u.ldq + hi * 8;
#pragma unroll
      for (int d0 = 0; d0 < 4; ++d0) qr[d0] = *(const bf16x8*)(qp + d0 * 16); }
    const bf16_t* ksrc = u.K + (size_t)(u.tok0 + (tid >> 3)) * u.ldk + (tid & 7) * 8;
    const bf16_t* vsrc = u.VT + (size_t)(tid >> 3) * MTOK + u.tok0 + (tid & 7) * 8;
    const int kdst = (tid & 7) * 1024 + (((tid >> 3) ^ (tid & 7)) * 16), vdst = (tid >> 3) * VPITCH + ((tid & 7) >> 1) * 32 + (tid & 1) * 8;
    u32x4 kreg, vreg[NVR];
    kreg = *(const u32x4*)(ksrc + (size_t)u.t_lo * 64 * u.ldk);
#pragma unroll
    for (int i = 0; i < NVR; ++i) vreg[i] = *(const u32x4*)(vsrc + (size_t)i * 64 * MTOK + u.t_lo * 64);
    *(FLAS u32x4*)(lds + L_K + kdst) = kreg;
#pragma unroll
    for (int i = 0; i < NVR; ++i) { *(FLAS u32x2*)(lds + L_V + vdst + i * 64 * VPITCH) = (u32x2){vreg[i].x, vreg[i].y}; *(FLAS u32x2*)(lds + L_V + vdst + i * 64 * VPITCH + 16) = (u32x2){vreg[i].z, vreg[i].w}; }
    __syncthreads();
    f32x16 o[NDB];
#pragma unroll
    for (int i = 0; i < NDB; ++i) o[i] = (f32x16){0.f,0.f,0.f,0.f,0.f,0.f,0.f,0.f,0.f,0.f,0.f,0.f,0.f,0.f,0.f,0.f};
    float mrun = 0.f, lsum = 0.f; bool first = true;
    const float NEG = -3.0e38f;
    const FLAS float* L = (const FLAS float*)(lds + L_LUT);
    const int gi = (u.q0 >> 6) + (wid >> 1);
    const int qc = 32 * (wid & 1) + r32;
    const int rstart = gi - 4 < 0 ? 0 : (gi - 4 > 120 ? 120 : gi - 4);
    const int cstart = qc - 8 < 0 ? 0 : (qc - 8 > 48 ? 48 : qc - 8);
    for (int t = u.t_lo; t < u.t_hi; ++t) {
        const int cur = (t - u.t_lo) & 1;
        const bool more = (t + 1 < u.t_hi);
        if (more) { kreg = *(const u32x4*)(ksrc + (size_t)(t + 1) * 64 * u.ldk);
#pragma unroll
            for (int i = 0; i < NVR; ++i) vreg[i] = *(const u32x4*)(vsrc + (size_t)i * 64 * MTOK + (t + 1) * 64); }
        const int k0 = t * 64;
        bool active = true;
        if (MODE == 1) active = (t >= rstart) && (t < rstart + 8);
        if (MODE == 2) active = (k0 + 63 >= q0w - 1024) && (k0 <= q0w + 31 + 1024);
        if (active) {
            f32x16 p0, p1;
            bf16x8 kf[8];
            { const FLAS unsigned char* kb = lds + L_K + cur * KBUF;
#pragma unroll
              for (int d0 = 0; d0 < 4; ++d0) { const int ko = (2 * d0 + hi) * 1024 + ((r32 ^ (2 * d0 + hi)) * 16); kf[2 * d0] = *(const FLAS bf16x8*)(kb + ko); kf[2 * d0 + 1] = *(const FLAS bf16x8*)(kb + ko + 512); } }
            float cb = 0.f; bool zinit = false;
            if (MODE == 0) { const int dmin = k0 - (q0w + 31), dmax = k0 + 63 - q0w;
                if (dmin >= 559) { cb = L[LUT_C + 600]; zinit = true; } else if (dmax <= -559) { cb = L[LUT_C - 600]; zinit = true; } }
            if (zinit) {
                const f32x16 z16 = {0.f,0.f,0.f,0.f,0.f,0.f,0.f,0.f,0.f,0.f,0.f,0.f,0.f,0.f,0.f,0.f};
                FA_SB();
                p0 = __builtin_amdgcn_mfma_f32_32x32x16_bf16(kf[0], qr[0], z16, 0, 0, 0); p1 = __builtin_amdgcn_mfma_f32_32x32x16_bf16(kf[1], qr[0], z16, 0, 0, 0);
#pragma unroll
                for (int d0 = 1; d0 < 4; ++d0) { p0 = __builtin_amdgcn_mfma_f32_32x32x16_bf16(kf[2 * d0], qr[d0], p0, 0, 0, 0); p1 = __builtin_amdgcn_mfma_f32_32x32x16_bf16(kf[2 * d0 + 1], qr[d0], p1, 0, 0, 0); }
            } else {
                if (MODE == 0 || MODE == 2) { const FLAS float* lp = L + (k0 - q + LUT_C + 4 * hi);
#pragma unroll
                    for (int r = 0; r < 16; ++r) { p0[r] = lp[(r & 3) + 8 * (r >> 2)]; p1[r] = lp[32 + (r & 3) + 8 * (r >> 2)]; }
                } else { const FLAS float* lp = L + ((t - gi + 7) * 128 + 63 - qc + 4 * hi);
#pragma unroll
                    for (int r = 0; r < 16; ++r) { const int kc = (r & 3) + 8 * (r >> 2) + 4 * hi;
                        const float v0 = lp[(r & 3) + 8 * (r >> 2)], v1 = lp[32 + (r & 3) + 8 * (r >> 2)];
                        p0[r] = ((unsigned)(kc - cstart) < 16u) ? v0 : NEG; p1[r] = ((unsigned)(kc + 32 - cstart) < 16u) ? v1 : NEG; } }
                FA_SB();
#pragma unroll
                for (int d0 = 0; d0 < 4; ++d0) { p0 = __builtin_amdgcn_mfma_f32_32x32x16_bf16(kf[2 * d0], qr[d0], p0, 0, 0, 0); p1 = __builtin_amdgcn_mfma_f32_32x32x16_bf16(kf[2 * d0 + 1], qr[d0], p1, 0, 0, 0); }
            }
            const FLAS unsigned char* vb = lds + L_V + cur * VBUF + r32 * VPITCH + hi * 16;
            u32x4 vf[2][NDB];
#pragma unroll
            for (int db = 0; db < NDB; ++db) vf[0][db] = *(const FLAS u32x4*)(vb + db * 32 * VPITCH);
            FA_SB();
            const float off = cb - mrun;
#pragma unroll
            for (int r = 0; r < 16; ++r) { p0[r] = p0[r] + off; p1[r] = p1[r] + off; }
            if (first || (((t - u.t_lo) & 3) == 0)) {
            float rm = __builtin_fmaxf(p0[0], p1[0]);
#pragma unroll
            for (int r = 1; r < 16; ++r) rm = __builtin_fmaxf(rm, __builtin_fmaxf(p0[r], p1[r]));
            rm = xhalf_max(rm);
            if (first) {
                const float dl = __builtin_fmaxf(rm, -1000.0f); mrun = dl;
#pragma unroll
                for (int r = 0; r < 16; ++r) { p0[r] = p0[r] - dl; p1[r] = p1[r] - dl; }
                first = false;
            } else if (__any(rm > 8.0f)) { const float dl = __builtin_fmaxf(rm, 0.0f); const float f = __builtin_amdgcn_exp2f(-dl); mrun += dl; lsum *= f;
#pragma unroll
                for (int i = 0; i < NDB; ++i) o[i] = o[i] * f;
#pragma unroll
                for (int r = 0; r < 16; ++r) { p0[r] = p0[r] - dl; p1[r] = p1[r] - dl; } }
            }
            float ps = 0.f;
#pragma unroll
            for (int r = 0; r < 16; ++r) { p0[r] = __builtin_amdgcn_exp2f(p0[r]); p1[r] = __builtin_amdgcn_exp2f(p1[r]); ps += p0[r] + p1[r]; }
            lsum += ps;
            u32x4 pw[4];
            pw[0] = (u32x4){cvtpk(p0[0], p0[1]), cvtpk(p0[2], p0[3]), cvtpk(p0[4], p0[5]), cvtpk(p0[6], p0[7])};
            pw[1] = (u32x4){cvtpk(p0[8], p0[9]), cvtpk(p0[10], p0[11]), cvtpk(p0[12], p0[13]), cvtpk(p0[14], p0[15])};
            pw[2] = (u32x4){cvtpk(p1[0], p1[1]), cvtpk(p1[2], p1[3]), cvtpk(p1[4], p1[5]), cvtpk(p1[6], p1[7])};
            pw[3] = (u32x4){cvtpk(p1[8], p1[9]), cvtpk(p1[10], p1[11]), cvtpk(p1[12], p1[13]), cvtpk(p1[14], p1[15])};
            FA_SB();
#pragma unroll
            for (int s = 0; s < 4; ++s) {
                if (s < 3) {
#pragma unroll
                    for (int db = 0; db < NDB; ++db) vf[(s + 1) & 1][db] = *(const FLAS u32x4*)(vb + db * 32 * VPITCH + (s + 1) * 32); }
#pragma unroll
                for (int db = 0; db < NDB; ++db) o[db] = __builtin_amdgcn_mfma_f32_32x32x16_bf16(__builtin_bit_cast(bf16x8, vf[s & 1][db]), __builtin_bit_cast(bf16x8, pw[s]), o[db], 0, 0, 0);
                FA_SB();
            }
        }
        if (more) { *(FLAS u32x4*)(lds + L_K + (cur ^ 1) * KBUF + kdst) = kreg;
#pragma unroll
            for (int i = 0; i < NVR; ++i) { *(FLAS u32x2*)(lds + L_V + (cur ^ 1) * VBUF + vdst + i * 64 * VPITCH) = (u32x2){vreg[i].x, vreg[i].y}; *(FLAS u32x2*)(lds + L_V + (cur ^ 1) * VBUF + vdst + i * 64 * VPITCH + 16) = (u32x2){vreg[i].z, vreg[i].w}; } }
        __syncthreads();
    }
    const float inv = 1.0f / xhalf_sum(lsum);
    bf16_t* op = u.O + (size_t)(u.tok0 + q) * u.ldo + 4 * hi;
#pragma unroll
    for (int db = 0; db < NDB; ++db)
#pragma unroll
        for (int g = 0; g < 4; ++g) { u32x2 w; w.x = cvtpk(o[db][4 * g] * inv, o[db][4 * g + 1] * inv); w.y = cvtpk(o[db][4 * g + 2] * inv, o[db][4 * g + 3] * inv);
            *(u32x2*)(op + db * 32 + 8 * g) = w; }
}

constexpr int LA_K = 0, LA_V = 2 * KBUF, LA_LUT = LA_V + 4 * VBUF, LA_END = LA_LUT + LUT_N * 4;
__device__ __forceinline__ void attn_unit_a(FLAS unsigned char* lds, const Unit u) {
    constexpr int NDB = 4;
    int tid_ = threadIdx.x; asm volatile("" : "+v"(tid_));
    const int tid = tid_, lane = tid & 63, r32 = lane & 31, hi = lane >> 5; const int wid = __builtin_amdgcn_readfirstlane(tid >> 6);
    const int q0w = u.q0 + 32 * wid, q = q0w + r32;
    if (u.load_lut) { FLAS float* Lw = (FLAS float*)(lds + LA_LUT); for (int i = tid; i < LUT_N; i += 512) Lw[i] = u.lut[i]; }
    bf16x8 qr[4];
    { const bf16_t* qp = u.Q + (size_t)(u.tok0 + q) * u.ldq + hi * 8;
#pragma unroll
      for (int d0 = 0; d0 < 4; ++d0) qr[d0] = *(const bf16x8*)(qp + d0 * 16); }
    const bf16_t* ksrc = u.K + (size_t)(u.tok0 + (tid >> 3)) * u.ldk + (tid & 7) * 8;
    const bf16_t* vsrc = u.VT + (size_t)(tid >> 3) * MTOK + u.tok0 + (tid & 7) * 8;
    const int kdst = (tid & 7) * 1024 + (((tid >> 3) ^ (tid & 7)) * 16), vdst = (tid >> 3) * VPITCH + ((tid & 7) >> 1) * 32 + (tid & 1) * 8;
    const int NT = u.t_hi - u.t_lo;
    u32x4 kreg, vreg[2];
#pragma unroll
    for (int j = 0; j < 2; ++j) {
        kreg = *(const u32x4*)(ksrc + (size_t)(u.t_lo + j) * 64 * u.ldk);
#pragma unroll
        for (int i = 0; i < 2; ++i) vreg[i] = *(const u32x4*)(vsrc + (size_t)i * 64 * MTOK + (u.t_lo + j) * 64);
        *(FLAS u32x4*)(lds + LA_K + j * KBUF + kdst) = kreg;
#pragma unroll
        for (int i = 0; i < 2; ++i) { *(FLAS u32x2*)(lds + LA_V + j * VBUF + vdst + i * 64 * VPITCH) = (u32x2){vreg[i].x, vreg[i].y}; *(FLAS u32x2*)(lds + LA_V + j * VBUF + vdst + i * 64 * VPITCH + 16) = (u32x2){vreg[i].z, vreg[i].w}; } }
    __syncthreads();
    const FLAS float* L = (const FLAS float*)(lds + LA_LUT);
    const f32x16 z16 = {0.f,0.f,0.f,0.f,0.f,0.f,0.f,0.f,0.f,0.f,0.f,0.f,0.f,0.f,0.f,0.f};
    f32x16 o[NDB];
#pragma unroll
    for (int i = 0; i < NDB; ++i) o[i] = z16;
    float mrun = 0.f, lsum = 0.f, fpend = 1.f; bool first = true, pend = false;
#define FA_BIAS(I, P0, P1, CB, ZI) do { const int k0_ = (u.t_lo + (I)) * 64; const int dmin_ = k0_ - (q0w + 31), dmax_ = k0_ + 63 - q0w; CB = 0.f; ZI = false; \
        if (dmin_ >= 559) { CB = L[LUT_C + 600]; ZI = true; } else if (dmax_ <= -559) { CB = L[LUT_C - 600]; ZI = true; } \
        else { const FLAS float* lp_ = L + (k0_ - q + LUT_C + 4 * hi); _Pragma("unroll") for (int r = 0; r < 16; ++r) { P0[r] = lp_[(r & 3) + 8 * (r >> 2)]; P1[r] = lp_[32 + (r & 3) + 8 * (r >> 2)]; } } } while (0)
#define FA_VFRAG(M) (*(const FLAS u32x4*)(vb_ + ((M) & 3) * 32 * VPITCH + ((M) >> 2) * 32))
#define FA_PVP(VSLOT, PW) do { const FLAS unsigned char* vb_ = lds + LA_V + (VSLOT) * VBUF + r32 * VPITCH + hi * 16; u32x4 vr_[4]; \
        _Pragma("unroll") for (int m_ = 0; m_ < 4; ++m_) vr_[m_] = FA_VFRAG(m_); \
        FA_SB(); \
        _Pragma("unroll") for (int m_ = 0; m_ < 16; ++m_) { \
            o[m_ & 3] = __builtin_amdgcn_mfma_f32_32x32x16_bf16(__builtin_bit_cast(bf16x8, vr_[m_ & 3]), __builtin_bit_cast(bf16x8, PW[m_ >> 2]), o[m_ & 3], 0, 0, 0); \
            if (m_ + 4 < 16) vr_[m_ & 3] = FA_VFRAG(m_ + 4); \
            FA_SB(); } } while (0)
    f32x16 pa0, pa1, pb0, pb1; float cbC = 0.f;
    { bool zi; FA_BIAS(0, pa0, pa1, cbC, zi); if (zi) { pa0 = z16; pa1 = z16; }
      const FLAS unsigned char* kb = lds + LA_K;
#pragma unroll
      for (int d0 = 0; d0 < 4; ++d0) { const int ko = (2 * d0 + hi) * 1024 + ((r32 ^ (2 * d0 + hi)) * 16); const bf16x8 a0 = *(const FLAS bf16x8*)(kb + ko), a1 = *(const FLAS bf16x8*)(kb + ko + 512);
          pa0 = __builtin_amdgcn_mfma_f32_32x32x16_bf16(a0, qr[d0], pa0, 0, 0, 0); pa1 = __builtin_amdgcn_mfma_f32_32x32x16_bf16(a1, qr[d0], pa1, 0, 0, 0); } }
    u32x4 pwa[4] = {{0u,0u,0u,0u},{0u,0u,0u,0u},{0u,0u,0u,0u},{0u,0u,0u,0u}}, pwb[4] = {{0u,0u,0u,0u},{0u,0u,0u,0u},{0u,0u,0u,0u},{0u,0u,0u,0u}};
    auto step = [&](const int i, f32x16& pC0, f32x16& pC1, f32x16& pN0, f32x16& pN1, u32x4 (&PWC)[4], u32x4 (&PWN)[4]) __attribute__((always_inline)) {
        if (pend) {
#pragma unroll
            for (int d = 0; d < NDB; ++d) o[d] = o[d] * fpend;
            pend = false; }
        if (i + 2 < NT) { kreg = *(const u32x4*)(ksrc + (size_t)(u.t_lo + i + 2) * 64 * u.ldk);
#pragma unroll
            for (int j = 0; j < 2; ++j) vreg[j] = *(const u32x4*)(vsrc + (size_t)j * 64 * MTOK + (u.t_lo + i + 2) * 64); }
        const int vsp = (i == 0) ? 0 : ((i - 1) & 3);
        const FLAS unsigned char* vb_ = lds + LA_V + vsp * VBUF + r32 * VPITCH + hi * 16;
        const FLAS unsigned char* kb = lds + LA_K + ((i + 1) & 1) * KBUF;
#define FA_KF(D0, H) (*(const FLAS bf16x8*)(kb + ((2 * (D0) + hi) * 1024 + ((r32 ^ (2 * (D0) + hi)) * 16)) + (H) * 512))
#define FA_PVM(G) do { o[(G) & 3] = __builtin_amdgcn_mfma_f32_32x32x16_bf16(__builtin_bit_cast(bf16x8, vr[(G) % 3]), __builtin_bit_cast(bf16x8, PWC[(G) >> 2]), o[(G) & 3], 0, 0, 0); if ((G) + 3 < 16) vr[(G) % 3] = FA_VFRAG((G) + 3); } while (0)
#define FA_EXP2(J, PX, R) do { const float e0_ = __builtin_amdgcn_exp2f(PX[R]), e1_ = __builtin_amdgcn_exp2f(PX[(R) + 1]); ps += e0_; ps += e1_; PWN[(J) >> 2][(J) & 3] = cvtpk(e0_, e1_); } while (0)
        u32x4 vr[3];
#pragma unroll
        for (int m = 0; m < 3; ++m) vr[m] = FA_VFRAG(m);
        const float off = cbC - mrun;
        FA_SB();
        float ra, rb, rm;
        FA_PVM(0); pC0[0] = fadd_s(pC0[0], off); pC1[0] = fadd_s(pC1[0], off); pC0[1] = fadd_s(pC0[1], off); pC1[1] = fadd_s(pC1[1], off); pC0[2] = fadd_s(pC0[2], off); pC1[2] = fadd_s(pC1[2], off); FA_SB();
        FA_PVM(1); ra = __builtin_fmaxf(__builtin_fmaxf(pC0[0], pC0[1]), pC0[2]); rb = __builtin_fmaxf(__builtin_fmaxf(pC1[0], pC1[1]), pC1[2]); pC0[3] = fadd_s(pC0[3], off); pC1[3] = fadd_s(pC1[3], off); pC0[4] = fadd_s(pC0[4], off); pC1[4] = fadd_s(pC1[4], off); FA_SB();
        FA_PVM(2); ra = __builtin_fmaxf(__builtin_fmaxf(ra, pC0[3]), pC0[4]); rb = __builtin_fmaxf(__builtin_fmaxf(rb, pC1[3]), pC1[4]); pC0[5] = fadd_s(pC0[5], off); pC1[5] = fadd_s(pC1[5], off); pC0[6] = fadd_s(pC0[6], off); pC1[6] = fadd_s(pC1[6], off); FA_SB();
        FA_PVM(3); ra = __builtin_fmaxf(__builtin_fmaxf(ra, pC0[5]), pC0[6]); rb = __builtin_fmaxf(__builtin_fmaxf(rb, pC1[5]), pC1[6]); pC0[7] = fadd_s(pC0[7], off); pC1[7] = fadd_s(pC1[7], off); pC0[8] = fadd_s(pC0[8], off); pC1[8] = fadd_s(pC1[8], off); FA_SB();
        FA_PVM(4); ra = __builtin_fmaxf(__builtin_fmaxf(ra, pC0[7]), pC0[8]); rb = __builtin_fmaxf(__builtin_fmaxf(rb, pC1[7]), pC1[8]); pC0[9] = fadd_s(pC0[9], off); pC1[9] = fadd_s(pC1[9], off); pC0[10] = fadd_s(pC0[10], off); pC1[10] = fadd_s(pC1[10], off); FA_SB();
        FA_PVM(5); ra = __builtin_fmaxf(__builtin_fmaxf(ra, pC0[9]), pC0[10]); rb = __builtin_fmaxf(__builtin_fmaxf(rb, pC1[9]), pC1[10]); pC0[11] = fadd_s(pC0[11], off); pC1[11] = fadd_s(pC1[11], off); pC0[12] = fadd_s(pC0[12], off); pC1[12] = fadd_s(pC1[12], off); FA_SB();
        FA_PVM(6); ra = __builtin_fmaxf(__builtin_fmaxf(ra, pC0[11]), pC0[12]); rb = __builtin_fmaxf(__builtin_fmaxf(rb, pC1[11]), pC1[12]); pC0[13] = fadd_s(pC0[13], off); pC1[13] = fadd_s(pC1[13], off); pC0[14] = fadd_s(pC0[14], off); pC1[14] = fadd_s(pC1[14], off); FA_SB();
        FA_PVM(7); ra = __builtin_fmaxf(__builtin_fmaxf(ra, pC0[13]), pC0[14]); rb = __builtin_fmaxf(__builtin_fmaxf(rb, pC1[13]), pC1[14]); pC0[15] = fadd_s(pC0[15], off); pC1[15] = fadd_s(pC1[15], off); ra = __builtin_fmaxf(__builtin_fmaxf(ra, pC0[15]), pC1[15]); rm = __builtin_fmaxf(ra, rb); FA_SB();
        rm = xhalf_max(rm);
        FA_SB();
        if (first || __any(rm > 8.0f)) {
            const float dl = __builtin_fmaxf(rm, first ? -1000.0f : 0.0f); const float f = first ? 1.0f : __builtin_amdgcn_exp2f(-dl);
            mrun = first ? dl : mrun + dl; lsum *= f; fpend = f; pend = !first; first = false;
#pragma unroll
            for (int r = 0; r < 16; ++r) { pC0[r] = pC0[r] - dl; pC1[r] = pC1[r] - dl; }
        }
        float ps = 0.f;
        bf16x8 kf[4];
#pragma unroll
        for (int g = 8; g < 16; ++g) { FA_PVM(g); FA_EXP2(g - 8, pC0, 2 * (g - 8));
            if (g == 12) { kf[0] = FA_KF(0, 0); kf[1] = FA_KF(0, 1); kf[2] = FA_KF(1, 0); kf[3] = FA_KF(1, 1); }
            FA_SB(); }
        float cbN; bool ziN; const int inx = (i + 1 < NT) ? i + 1 : NT - 1;
        FA_BIAS(inx, pN0, pN1, cbN, ziN);
        FA_SB();
        if (ziN) { pN0 = __builtin_amdgcn_mfma_f32_32x32x16_bf16(kf[0], qr[0], z16, 0, 0, 0); FA_EXP2(8, pC1, 0); FA_SB(); pN1 = __builtin_amdgcn_mfma_f32_32x32x16_bf16(kf[1], qr[0], z16, 0, 0, 0); }
        else { pN0 = __builtin_amdgcn_mfma_f32_32x32x16_bf16(kf[0], qr[0], pN0, 0, 0, 0); FA_EXP2(8, pC1, 0); FA_SB(); pN1 = __builtin_amdgcn_mfma_f32_32x32x16_bf16(kf[1], qr[0], pN1, 0, 0, 0); }
        kf[0] = FA_KF(2, 0); kf[1] = FA_KF(2, 1); FA_EXP2(9, pC1, 2); FA_SB();
        pN0 = __builtin_amdgcn_mfma_f32_32x32x16_bf16(kf[2], qr[1], pN0, 0, 0, 0); FA_EXP2(10, pC1, 4); FA_SB();
        pN1 = __builtin_amdgcn_mfma_f32_32x32x16_bf16(kf[3], qr[1], pN1, 0, 0, 0); kf[2] = FA_KF(3, 0); kf[3] = FA_KF(3, 1); FA_EXP2(11, pC1, 6); FA_SB();
        pN0 = __builtin_amdgcn_mfma_f32_32x32x16_bf16(kf[0], qr[2], pN0, 0, 0, 0); FA_EXP2(12, pC1, 8); FA_SB();
        pN1 = __builtin_amdgcn_mfma_f32_32x32x16_bf16(kf[1], qr[2], pN1, 0, 0, 0); FA_EXP2(13, pC1, 10); FA_SB();
        pN0 = __builtin_amdgcn_mfma_f32_32x32x16_bf16(kf[2], qr[3], pN0, 0, 0, 0); FA_EXP2(14, pC1, 12); FA_SB();
        pN1 = __builtin_amdgcn_mfma_f32_32x32x16_bf16(kf[3], qr[3], pN1, 0, 0, 0); FA_EXP2(15, pC1, 14); FA_SB();
#undef FA_KF
#undef FA_PVM
#undef FA_EXP2
        lsum += ps; cbC = cbN;
        if (i + 2 < NT) { *(FLAS u32x4*)(lds + LA_K + (i & 1) * KBUF + kdst) = kreg;
#pragma unroll
            for (int j = 0; j < 2; ++j) { *(FLAS u32x2*)(lds + LA_V + ((i + 2) & 3) * VBUF + vdst + j * 64 * VPITCH) = (u32x2){vreg[j].x, vreg[j].y}; *(FLAS u32x2*)(lds + LA_V + ((i + 2) & 3) * VBUF + vdst + j * 64 * VPITCH + 16) = (u32x2){vreg[j].z, vreg[j].w}; } }
        __syncthreads();
    };
    for (int i = 0; i < NT; i += 2) { step(i, pa0, pa1, pb0, pb1, pwa, pwb); if (i + 1 < NT) step(i + 1, pb0, pb1, pa0, pa1, pwb, pwa); }
    if (pend) {
#pragma unroll
        for (int d = 0; d < NDB; ++d) o[d] = o[d] * fpend; }
    if (NT & 1) { FA_PVP((NT - 1) & 3, pwb); } else { FA_PVP((NT - 1) & 3, pwa); }
#undef FA_BIAS
#undef FA_PVP
#undef FA_VFRAG
    const float inv = 1.0f / xhalf_sum(lsum);
    bf16_t* op = u.O + (size_t)(u.tok0 + q) * u.ldo + 4 * hi;
#pragma unroll
    for (int db = 0; db < NDB; ++db)
#pragma unroll
        for (int g = 0; g < 4; ++g) { u32x2 w; w.x = cvtpk(o[db][4 * g] * inv, o[db][4 * g + 1] * inv); w.y = cvtpk(o[db][4 * g + 2] * inv, o[db][4 * g + 3] * inv);
            *(u32x2*)(op + db * 32 + 8 * g) = w; }
    __syncthreads();
}
}
#define LAS __attribute__((address_space(3)))
typedef unsigned short bf16;
typedef unsigned v4u __attribute__((ext_vector_type(4)));
typedef float f32x4 __attribute__((ext_vector_type(4)));
constexpr int NWAVES = 8;
constexpr int DM = 1024, BATCH = 4, SEQ = 8192, MTOK = BATCH * SEQ, DFF = 2816, INC = 7680, DEPTH = 2;
constexpr float EPS = 1e-6f, LOG2E = 1.4426950408889634f, QSCALE = 0.125f * 1.4426950408889634f;
constexpr size_t MiB = 1u << 20;
constexpr size_t WS_LUTA = 0;
constexpr size_t WS_LUTC = 64 * 1024;
constexpr size_t WS_LUTB = 192 * 1024;
constexpr size_t WS_W = 1 * MiB;
constexpr size_t W_13A = WS_W, W_2A = W_13A + 11 * MiB, W_13B = W_2A + 5632 * 1024, W_2B = W_13B + 11 * MiB;
constexpr size_t W_QK = W_2B + 5632 * 1024, W_V = W_QK + 6 * MiB, W_G = W_V + 3 * MiB, W_BR = W_G + 6 * MiB, W_O = W_BR + 3 * MiB, W_END = W_O + 2 * MiB;
static_assert(W_END == 54 * MiB, "weights");
constexpr size_t WS_XN = 54 * MiB;
constexpr size_t WS_QP = 118 * MiB;
constexpr size_t WS_KP = 214 * MiB;
constexpr size_t WS_VT = 310 * MiB;
constexpr size_t WS_O12 = 406 * MiB;
constexpr size_t WS_END = 470 * MiB;
constexpr size_t WS_U = WS_QP;
constexpr size_t WS_G = WS_KP;
constexpr int LDS_BYTES = 147456;
constexpr size_t WS_BAR = 512 * 1024, BAR_BYTES = 16384;
constexpr int LDS_MISC = 131072 + 64;
#define XB_TMO      128
#define XB_XCNT(j)  (256  + 64 * (j))
#define XB_XSUB(j)  (1280 + 64 * (j))
#define XB_XGEN(j)  (2304 + 64 * (j))
#define XB_TOP      3328
#define XB_TOPGEN   3392
#define XCD_BAR_WORDS 3456
#define XB_SPIN_CAP (1u << 18)

__device__ __forceinline__ unsigned xb_ld(unsigned* p)              { return __hip_atomic_load(p, __ATOMIC_RELAXED, __HIP_MEMORY_SCOPE_AGENT); }
__device__ __forceinline__ unsigned xb_add(unsigned* p, unsigned v) { return __hip_atomic_fetch_add(p, v, __ATOMIC_RELAXED, __HIP_MEMORY_SCOPE_AGENT); }
__device__ __forceinline__ unsigned xb_xcc_id() { return (unsigned)__builtin_amdgcn_s_getreg((3 << 11) | 20) & 0xFu; }
#define XB_SPIN(cond, bar) do { unsigned _sp = 0; while (cond) { __builtin_amdgcn_s_sleep(1); \
    if ((++_sp & 255u) == 0u) { if (xb_ld(&(bar)[XB_TMO])) break; if (_sp > XB_SPIN_CAP) { __hip_atomic_store(&(bar)[XB_TMO], 1u, __ATOMIC_RELAXED, __HIP_MEMORY_SCOPE_AGENT); break; } } } } while (0)

struct XcdBarrier {
    unsigned* bar; unsigned x;
    volatile LAS unsigned* st;
};

__device__ __forceinline__ XcdBarrier xcd_barrier_post(unsigned* bar, volatile LAS unsigned* st) {
    XcdBarrier b; b.bar = bar; b.x = xb_xcc_id(); b.st = st;
    if (threadIdx.x == 0) (void)xb_add(&bar[XB_XCNT(b.x)], 1u);
    return b;
}
__device__ __forceinline__ void xcd_barrier_complete(unsigned* bar, unsigned x, unsigned& nloc, unsigned& nx) {
    const unsigned G = gridDim.x * gridDim.y * gridDim.z;
    unsigned sum, cnt, mine, sp = 0u;
    for (;;) {
        sum = 0u; cnt = 0u; mine = 0u;
#pragma unroll
        for (unsigned j = 0; j < 16; ++j) { const unsigned c = xb_ld(&bar[XB_XCNT(j)]); sum += c; cnt += (c > 0u) ? 1u : 0u; mine = (j == x) ? c : mine; }
        if (sum == G) break;
        __builtin_amdgcn_s_sleep(1);
        if ((++sp & 255u) == 0u) { if (xb_ld(&bar[XB_TMO])) break; if (sp > XB_SPIN_CAP) { __hip_atomic_store(&bar[XB_TMO], 1u, __ATOMIC_RELAXED, __HIP_MEMORY_SCOPE_AGENT); break; } }
    }
    nloc = mine > 0u ? mine : 1u; nx = cnt > 0u ? cnt : 1u;
}

__device__ __forceinline__ void xcd_barrier(const XcdBarrier& b) {
    asm volatile("s_waitcnt vmcnt(0)" ::: "memory");
    __syncthreads();
    if (threadIdx.x == 0) {
        unsigned* bar = b.bar;
        __builtin_amdgcn_s_waitcnt(0);
        unsigned nloc = b.st[0], nx = b.st[1];
        if (nloc == 0u) { xcd_barrier_complete(bar, b.x, nloc, nx); b.st[0] = nloc; b.st[1] = nx; }
        const unsigned old = xb_add(&bar[XB_XSUB(b.x)], 1u);
        const unsigned gen = old / nloc;
        if (old + 1u == (gen + 1u) * nloc) {
            __builtin_amdgcn_fence(__ATOMIC_RELEASE, "agent");
            asm volatile("s_waitcnt vmcnt(0)" ::: "memory");
            const unsigned og = xb_add(&bar[XB_TOP], 1u);
            const unsigned tg = og / nx;
            if (og + 1u == (tg + 1u) * nx) xb_add(&bar[XB_TOPGEN], 1u);
            else XB_SPIN(xb_ld(&bar[XB_TOPGEN]) == tg, bar);
            __builtin_amdgcn_fence(__ATOMIC_ACQUIRE, "agent");
            xb_add(&bar[XB_XGEN(b.x)], 1u);
            asm volatile("s_waitcnt vmcnt(0)" ::: "memory");
        } else {
            XB_SPIN(xb_ld(&bar[XB_XGEN(b.x)]) == gen, bar);
            __builtin_amdgcn_fence(__ATOMIC_ACQUIRE, "agent");
            asm volatile("s_waitcnt vmcnt(0)" ::: "memory");
        }
    }
    __syncthreads();
}


#ifndef GACT
#define GACT 2
#endif
#ifndef BR_N
#define BR_N 3
#endif
#ifndef STOP_AFTER
#define STOP_AFTER 0
#endif
#ifndef PHASE_MASK
#define PHASE_MASK 0xFFFF
#endif
#define PH(b) ((PHASE_MASK >> (b)) & 1)
struct Params { const float* in[23]; float* out; unsigned char* ws; };

__device__ __forceinline__ unsigned f2bf(float f) { unsigned u = __builtin_bit_cast(unsigned, f); return (u + 0x7fffu + ((u >> 16) & 1u)) >> 16; }
__device__ __forceinline__ unsigned pk2(float lo, float hi) { return f2bf(lo) | (f2bf(hi) << 16); }
__device__ __forceinline__ float wave_sum(float v, int lane) {
#pragma unroll
    for (int o = 1; o < 64; o <<= 1) v += __builtin_bit_cast(float, __builtin_amdgcn_ds_bpermute((lane ^ o) << 2, __builtin_bit_cast(int, v)));
    return v;
}
__device__ __forceinline__ void transpose_item(const float* W, int ldw, int k0, int n0, bf16* WT, int ldt, int drow, LAS float* scr, int lane) {
    float wv[32];
#pragma unroll
    for (int i = 0; i < 32; ++i) wv[i] = W[(size_t)(k0 + 2 * i + (lane >> 5)) * ldw + n0 + (lane & 31)];
#pragma unroll
    for (int i = 0; i < 32; ++i) scr[(2 * i + (lane >> 5)) * 33 + (lane & 31)] = wv[i];
    asm volatile("s_waitcnt lgkmcnt(0)" ::: "memory");
    const int c = lane & 7;
#pragma unroll
    for (int j = 0; j < 4; ++j) { const int n = (lane >> 3) + 8 * j; const LAS float* s = scr + (8 * c) * 33 + n;
        v4u o; o.x = pk2(s[0 * 33], s[1 * 33]); o.y = pk2(s[2 * 33], s[3 * 33]); o.z = pk2(s[4 * 33], s[5 * 33]); o.w = pk2(s[6 * 33], s[7 * 33]);
        *(v4u*)(WT + (size_t)(drow + n) * ldt + k0 + 8 * c) = o; }
    asm volatile("s_waitcnt lgkmcnt(0)" ::: "memory");
}
__device__ __forceinline__ int t5_bucket(int rel) {
    const int n = rel < 0 ? -rel : rel;
    int b = n < 8 ? n : 8 + (n >= 15) + (n >= 27) + (n >= 50) + (n >= 91) + (n >= 166) + (n >= 305) + (n >= 559);
    return b + (rel > 0 ? 16 : 0);
}
__device__ __forceinline__ void convert_weights(const Params& P, int l, LAS unsigned char* lds, int gw, int ngw, int wave, int lane) {
    LAS float* scr = (LAS float*)(lds + wave * 16384);
    unsigned char* ws = P.ws;
    constexpr int I_UP = 16 * 88, I_DN = 44 * 32, I_IN = 16 * 240, I_BR = 8 * 32, I_O = 16 * 32;
    constexpr int NITEMS = 4 * I_UP + 2 * I_DN + I_IN + 3 * I_BR + I_O;
    for (int it = gw; it < NITEMS; it += ngw) {
        int r = it;
        if (r < 4 * I_UP) {
            const int which = r / I_UP; r -= which * I_UP; const int kb = r / 88, nb = r % 88, n0 = nb * 32;
            const float* W = (which == 0 ? P.in[2] : which == 1 ? P.in[3] : which == 2 ? P.in[19] : P.in[20]) + (size_t)l * DM * DFF;
            bf16* WT = (bf16*)(ws + (which < 2 ? W_13A : W_13B));
            const int drow = (n0 >> 7) * 256 + (which & 1) * 128 + (n0 & 127);
            transpose_item(W, DFF, kb * 64, n0, WT, DM, drow, scr, lane); continue; }
        r -= 4 * I_UP;
        if (r < 2 * I_DN) {
            const int which = r / I_DN; r -= which * I_DN; const int kb = r / 32, nb = r % 32;
            const float* W = (which == 0 ? P.in[4] : P.in[21]) + (size_t)l * DFF * DM;
            transpose_item(W, DM, kb * 64, nb * 32, (bf16*)(ws + (which == 0 ? W_2A : W_2B)), DFF, nb * 32, scr, lane); continue; }
        r -= 2 * I_DN;
        if (r < I_IN) {
            const int kb = r / 240, nb = r % 240, n0 = nb * 32; const float* W = P.in[6] + (size_t)l * DM * INC;
            const int seg = n0 >> 9, off = n0 & 511; bf16* WT; int drow;
            if (seg >= 9) { WT = (bf16*)(ws + W_G); drow = n0 - 4608; }
            else { const int br = seg / 3, kind = seg % 3;
                if (kind == 2) { WT = (bf16*)(ws + W_V); drow = br * 512 + off; }
                else { WT = (bf16*)(ws + W_QK); drow = kind * 1536 + br * 512 + off; } }
            transpose_item(W, INC, kb * 64, n0, WT, DM, drow, scr, lane); continue; }
        r -= I_IN;
        if (r < 3 * I_BR) {
            const int which = r / I_BR; r -= which * I_BR; const int kb = r / 32, nb = r % 32;
            const float* W = (which == 0 ? P.in[14] : which == 1 ? P.in[15] : P.in[16]) + (size_t)l * 512 * DM;
            transpose_item(W, DM, kb * 64, nb * 32, (bf16*)(ws + W_BR) + (size_t)which * DM * 512, 512, nb * 32, scr, lane); continue; }
        r -= 3 * I_BR;
        { const int kb = r / 32, nb = r % 32; const float* W = P.in[17] + (size_t)l * DM * DM;
          transpose_item(W, DM, kb * 64, nb * 32, (bf16*)(ws + W_O), DM, nb * 32, scr, lane); }
    }
}
__device__ __forceinline__ void build_luts(const Params& P, int gtid, int gthreads) {
    const float* t5 = P.in[13]; const float* rpb = P.in[12];
    float* la = (float*)(P.ws + WS_LUTA); float* lc = (float*)(P.ws + WS_LUTC); float* lb = (float*)(P.ws + WS_LUTB);
    for (int i = gtid; i < 4 * fa::LUT_N; i += gthreads) { const int h = i / fa::LUT_N, d = i % fa::LUT_N - fa::LUT_C; la[i] = t5[t5_bucket(d) * 12 + h] * LOG2E; }
    for (int i = gtid; i < 8 * fa::LUT_N; i += gthreads) { const int h = i / fa::LUT_N, d = i % fa::LUT_N - fa::LUT_C; const int n = d < 0 ? -d : d;
        const int mult = (n <= 64) + ((n & 3) == 0 && n <= 256) + ((n & 15) == 0 && n <= 1024);
        lc[i] = mult == 0 ? -3.0e38f : t5[t5_bucket(d) * 12 + 4 + h] * LOG2E + (mult == 1 ? 0.f : mult == 2 ? 1.0f : 1.5849625007211562f); }
    for (int i = gtid; i < 2 * 8 * 15 * 128; i += gthreads) { const int c = i & 127, rr = (i >> 7) % 15, lh = i / (15 * 128); const int rc = c - 48;
        lb[i] = (rc >= 0 && rc < 31) ? rpb[(size_t)(lh * 15 + rr) * 31 + rc] * LOG2E : 0.f; }
}
__device__ __forceinline__ void rms_row2(const float* xrow0, const float* xrow1, const float* g, bf16* xo0, bf16* xo1, float* fo0, float* fo1, int lane) {
    const f32x4* xr0 = (const f32x4*)xrow0 + lane; const f32x4* xr1 = (const f32x4*)xrow1 + lane; const f32x4* gr = (const f32x4*)g + lane;
    f32x4 v0[4], v1[4]; float s0 = 0.f, s1 = 0.f;
#pragma unroll
    for (int j = 0; j < 4; ++j) { v0[j] = xr0[64 * j]; v1[j] = xr1[64 * j]; }
#pragma unroll
    for (int j = 0; j < 4; ++j) { s0 += (v0[j].x * v0[j].x + v0[j].y * v0[j].y) + (v0[j].z * v0[j].z + v0[j].w * v0[j].w); s1 += (v1[j].x * v1[j].x + v1[j].y * v1[j].y) + (v1[j].z * v1[j].z + v1[j].w * v1[j].w); }
    const float r0 = 1.0f / sqrtf(wave_sum(s0, lane) * (1.f / DM) + EPS), r1 = 1.0f / sqrtf(wave_sum(s1, lane) * (1.f / DM) + EPS);
#pragma unroll
    for (int j = 0; j < 4; ++j) { const f32x4 gg = gr[64 * j]; const f32x4 y0 = v0[j] * r0 * gg, y1 = v1[j] * r1 * gg;
        if (xo0) { ((unsigned long long*)xo0)[lane + 64 * j] = (unsigned long long)pk2(y0.x, y0.y) | ((unsigned long long)pk2(y0.z, y0.w) << 32);
                   ((unsigned long long*)xo1)[lane + 64 * j] = (unsigned long long)pk2(y1.x, y1.y) | ((unsigned long long)pk2(y1.z, y1.w) << 32); }
        else { ((f32x4*)fo0)[lane + 64 * j] = y0; ((f32x4*)fo1)[lane + 64 * j] = y1; } }
}
__device__ __forceinline__ void diff_combine(const Params& P, int l, int gw, int ngw, int lane) {
    const float* lq1 = P.in[7] + l * 64; const float* lk1 = P.in[8] + l * 64; const float* lq2 = P.in[9] + l * 64; const float* lk2 = P.in[10] + l * 64;
    const float s1 = wave_sum(lq1[lane] * lk1[lane], lane), s2 = wave_sum(lq2[lane] * lk2[lane], lane);
    const float lam_init = 0.8f - 0.6f * expf(-0.3f * (float)l);
    const float lam = expf(s1) - expf(s2) + lam_init;
    const float* sg = P.in[11] + l * 128; const float g0 = sg[2 * lane] * (1.f - lam_init), g1 = sg[2 * lane + 1] * (1.f - lam_init);
    const unsigned* O1 = (const unsigned*)(P.ws + WS_O12); const unsigned* O2 = O1 + (size_t)MTOK * 256;
    bf16* QP = (bf16*)(P.ws + WS_QP);
    for (int it0 = gw; it0 < MTOK * 4; it0 += 4 * ngw) {
        unsigned a[4], b[4]; int itk[4];
#pragma unroll
        for (int k = 0; k < 4; ++k) { const int it = it0 + k * ngw; itk[k] = it < MTOK * 4 ? it : it0; const int row = itk[k] >> 2, h = itk[k] & 3;
            a[k] = O1[(size_t)row * 256 + h * 64 + lane]; b[k] = O2[(size_t)row * 256 + h * 64 + lane]; }
#pragma unroll
        for (int k = 0; k < 4; ++k) { const int row = itk[k] >> 2, h = itk[k] & 3;
            const float x0 = __builtin_bit_cast(float, a[k] << 16) - lam * __builtin_bit_cast(float, b[k] << 16), x1 = __builtin_bit_cast(float, a[k] & 0xffff0000u) - lam * __builtin_bit_cast(float, b[k] & 0xffff0000u);
            const float r = 1.0f / sqrtf(wave_sum(x0 * x0 + x1 * x1, lane) * (1.f / 128.f) + EPS);
            ((unsigned*)(QP + (size_t)row * 1536 + h * 128))[lane] = pk2(x0 * r * g0, x1 * r * g1); } }
}

__global__ void __launch_bounds__(NWAVES * 64, 2) fwd_megakernel(Params P) {
    extern __shared__ __attribute__((aligned(16))) unsigned char lds_raw[];
    cg::grid_group grid = cg::this_grid();
    LAS unsigned char* lds = (LAS unsigned char*)lds_raw;
    const int tid = threadIdx.x, lane = tid & 63, wave = __builtin_amdgcn_readfirstlane(tid >> 6);
    const int G = gridDim.x, bx = blockIdx.x;
    const int vcu = (G % 8 == 0) ? (bx % 8) * (G / 8) + bx / 8 : bx;
    const int gw = vcu * NWAVES + wave, ngw = G * NWAVES;
    unsigned char* ws = P.ws;
    bf16* XN = (bf16*)(ws + WS_XN); bf16* QP = (bf16*)(ws + WS_QP); bf16* KP = (bf16*)(ws + WS_KP); bf16* VT = (bf16*)(ws + WS_VT);
    bf16* O12 = (bf16*)(ws + WS_O12); bf16* MG = O12; bf16* U = (bf16*)(ws + WS_U); bf16* GT = (bf16*)(ws + WS_G);
    float* X = P.out;
    if (tid < 2) ((volatile LAS unsigned*)(lds + LDS_MISC))[tid] = 0u;
    __syncthreads();
    const XcdBarrier xbar = xcd_barrier_post((unsigned*)(ws + WS_BAR), (volatile LAS unsigned*)(lds + LDS_MISC));
    grid.sync();
    int bxo = bx;
#define GSYNC() xcd_barrier(xbar)
#define OPQ(v) asm volatile("" : "+s"(v) :: "memory")
#define OPQV(v) asm volatile("" : "+v"(v) :: "memory")
    int lno = 0;

#pragma unroll 1
    for (int l = 0; l < DEPTH; ++l) {
        lno = (int)threadIdx.x; OPQV(lno); lno &= 63; if (PH(0)) convert_weights(P, l, lds, gw, ngw, wave, lno);
        if (PH(0) && l == 0) build_luts(P, bx * NWAVES * 64 + wave * 64 + lno, G * NWAVES * 64);
        { const float* xs = (l == 0) ? P.in[0] : X;
          for (int m = gw; m < MTOK; m += 2 * ngw) { const int m1 = (m + ngw < MTOK) ? m + ngw : m; rms_row2(xs + (size_t)m * DM, xs + (size_t)m1 * DM, P.in[1] + l * DM, XN + (size_t)m * DM, XN + (size_t)m1 * DM, nullptr, nullptr, lno); } }
        GSYNC();
        if (PH(1)) { pg8::Gemm g{XN, (const bf16*)(ws + W_13A), MTOK, 2 * DFF, DM, DM, DM}; pg8::StaticOrder S; OPQ(bxo); S.init(MTOK, 2 * DFF, G, bxo);
          pg8::EpiSwiGLU E{U, DFF}; pg8::gemm_phase<pg8::EpiSwiGLU, pg8::StaticOrder, true, true>(lds, g, S, E); }
        GSYNC();
        if (PH(2)) { pg8::Gemm g{U, (const bf16*)(ws + W_2A), MTOK, DM, DFF, DFF, DFF}; pg8::StaticOrder S; OPQ(bxo); S.init(MTOK, DM, G, bxo);
          pg8::EpiResid E{(l == 0) ? P.in[0] : X, X, DM, 0.5f}; pg8::gemm_phase<pg8::EpiResid, pg8::StaticOrder, true, true>(lds, g, S, E); }
        GSYNC();
        if (STOP_AFTER == 1) break;
        lno = (int)threadIdx.x; OPQV(lno); lno &= 63; for (int m = gw; m < MTOK; m += 2 * ngw) { const int m1 = (m + ngw < MTOK) ? m + ngw : m; rms_row2(X + (size_t)m * DM, X + (size_t)m1 * DM, P.in[5] + l * DM, XN + (size_t)m * DM, XN + (size_t)m1 * DM, nullptr, nullptr, lno); }
        GSYNC();
        if (PH(3)) { pg8::Gemm g{XN, (const bf16*)(ws + W_QK), MTOK, 3072, DM, DM, DM}; pg8::StaticOrder S; OPQ(bxo); S.init(MTOK, 3072, G, bxo);
          pg8::EpiBf16<0> E{QP, 1536, 1536, (size_t)MTOK * 1536, QSCALE}; pg8::gemm_phase<pg8::EpiBf16<0>, pg8::StaticOrder, true, true>(lds, g, S, E); }
        if (PH(3)) { pg8::Gemm g{(const bf16*)(ws + W_V), XN, 1536, MTOK, DM, DM, DM}; pg8::StaticOrder S; OPQ(bxo); S.init(1536, MTOK, G, bxo);
          pg8::EpiBf16<0> E{VT, MTOK, 0, 0, 1.f}; pg8::gemm_phase<pg8::EpiBf16<0>, pg8::StaticOrder, true, true>(lds, g, S, E); }
        GSYNC();
        int prev_h = -1;
        if (PH(4)) for (int un = vcu; un < 1024; un += G) { const int combo = (un & 255) >> 3, qb = (un & 7) + 8 * (un >> 8);
            const int b = combo >> 3, h = (combo >> 1) & 3, m = combo & 1;
            fa::Unit u; u.load_lut = (h != prev_h); prev_h = h; u.Q = QP + h * 128 + m * 64; u.K = KP + h * 128 + m * 64; u.VT = VT + (size_t)(h * 128) * MTOK; u.O = O12 + (size_t)m * MTOK * 512 + h * 128;
            u.lut = (const float*)(ws + WS_LUTA) + h * fa::LUT_N; u.ldq = 1536; u.ldk = 1536; u.ldo = 512; u.tok0 = b * SEQ; u.q0 = qb * 256; u.t_lo = 0; u.t_hi = SEQ / 64;
            fa::attn_unit_a(lds, u); }
        prev_h = -1;
        if (PH(5)) for (int un = vcu; un < 1024; un += G) { const int combo = (un & 255) >> 3, qb = (un & 7) + 8 * (un >> 8);
            const int b = combo >> 3, h = combo & 7;
            fa::Unit u; u.load_lut = (h != prev_h); prev_h = h; u.Q = QP + 1024 + h * 64; u.K = KP + 1024 + h * 64; u.VT = VT + (size_t)(1024 + h * 64) * MTOK; u.O = QP + 1024 + h * 64;
            u.lut = (const float*)(ws + WS_LUTC) + h * fa::LUT_N; u.ldq = 1536; u.ldk = 1536; u.ldo = 1536; u.tok0 = b * SEQ; u.q0 = qb * 256;
            const int lo = qb * 4 - 16, hi2 = qb * 4 + 20; u.t_lo = lo < 0 ? 0 : lo; u.t_hi = hi2 > SEQ / 64 ? SEQ / 64 : hi2;
            fa::attn_unit<2>(lds, u); }
        prev_h = -1;
        if (PH(6)) for (int un = vcu; un < 1024; un += G) { const int combo = (un & 255) >> 3, qb = (un & 7) + 8 * (un >> 8);
            const int b = combo >> 3, h = combo & 7;
            fa::Unit u; u.load_lut = (h != prev_h); prev_h = h; u.Q = QP + 512 + h * 64; u.K = KP + 512 + h * 64; u.VT = VT + (size_t)(512 + h * 64) * MTOK; u.O = QP + 512 + h * 64;
            u.lut = (const float*)(ws + WS_LUTB) + (size_t)(l * 8 + h) * 15 * 128; u.ldq = 1536; u.ldk = 1536; u.ldo = 1536; u.tok0 = b * SEQ; u.q0 = qb * 256;
            const int g0 = qb * 4, g3 = qb * 4 + 3; const int r0 = g0 - 4 < 0 ? 0 : (g0 - 4 > 120 ? 120 : g0 - 4), r3 = g3 - 4 < 0 ? 0 : (g3 - 4 > 120 ? 120 : g3 - 4);
            u.t_lo = r0; u.t_hi = r3 + 8;
            fa::attn_unit<1>(lds, u); }
        GSYNC();
        lno = (int)threadIdx.x; OPQV(lno); lno &= 63; if (PH(7)) diff_combine(P, l, gw, ngw, lno);
        if (PH(8)) { pg8::Gemm g{XN, (const bf16*)(ws + W_G), MTOK, 3072, DM, DM, DM}; pg8::StaticOrder S; OPQ(bxo); S.init(MTOK, 3072, G, bxo);
          pg8::EpiBf16<GACT> E{GT, DM, DM, (size_t)MTOK * DM, 1.f}; pg8::gemm_phase<pg8::EpiBf16<GACT>, pg8::StaticOrder, true, true>(lds, g, S, E); }
        GSYNC();
#pragma unroll 1
        for (int i = 0; i < BR_N * PH(9); ++i) { pg8::Gemm g{QP + i * 512, (const bf16*)(ws + W_BR) + (size_t)i * DM * 512, MTOK, DM, 512, 1536, 512}; pg8::StaticOrder S; OPQ(bxo); S.init(MTOK, DM, G, bxo);
            pg8::EpiGate E{GT + (size_t)i * MTOK * DM, MG, DM, i == 0}; pg8::gemm_phase<pg8::EpiGate, pg8::StaticOrder, true, true>(lds, g, S, E);
            __builtin_amdgcn_fence(__ATOMIC_ACQUIRE, "agent"); asm volatile("s_waitcnt vmcnt(0)" ::: "memory"); }
        GSYNC();
        if (PH(10)) { pg8::Gemm g{MG, (const bf16*)(ws + W_O), MTOK, DM, DM, DM, DM}; pg8::StaticOrder S; OPQ(bxo); S.init(MTOK, DM, G, bxo);
          pg8::EpiResid E{X, X, DM, 1.0f}; pg8::gemm_phase<pg8::EpiResid, pg8::StaticOrder, true, true>(lds, g, S, E); }
        GSYNC();
        if (STOP_AFTER == 2) break;
        lno = (int)threadIdx.x; OPQV(lno); lno &= 63; for (int m = gw; m < MTOK; m += 2 * ngw) { const int m1 = (m + ngw < MTOK) ? m + ngw : m; rms_row2(X + (size_t)m * DM, X + (size_t)m1 * DM, P.in[18] + l * DM, XN + (size_t)m * DM, XN + (size_t)m1 * DM, nullptr, nullptr, lno); }
        GSYNC();
        if (PH(11)) { pg8::Gemm g{XN, (const bf16*)(ws + W_13B), MTOK, 2 * DFF, DM, DM, DM}; pg8::StaticOrder S; OPQ(bxo); S.init(MTOK, 2 * DFF, G, bxo);
          pg8::EpiSwiGLU E{U, DFF}; pg8::gemm_phase<pg8::EpiSwiGLU, pg8::StaticOrder, true, true>(lds, g, S, E); }
        GSYNC();
        if (PH(12)) { pg8::Gemm g{U, (const bf16*)(ws + W_2B), MTOK, DM, DFF, DFF, DFF}; pg8::StaticOrder S; OPQ(bxo); S.init(MTOK, DM, G, bxo);
          pg8::EpiResid E{X, X, DM, 0.5f}; pg8::gemm_phase<pg8::EpiResid, pg8::StaticOrder, true, true>(lds, g, S, E); }
        GSYNC();
        if (STOP_AFTER == 3) break;
    }
    lno = (int)threadIdx.x; OPQV(lno); lno &= 63; for (int m = gw; m < MTOK; m += 2 * ngw) { const int m1 = (m + ngw < MTOK) ? m + ngw : m; rms_row2(X + (size_t)m * DM, X + (size_t)m1 * DM, P.in[22], nullptr, nullptr, X + (size_t)m * DM, X + (size_t)m1 * DM, lno); }
}

extern "C" void kernel_launch(void* const* d_in, const int* in_sizes, int n_in, void* d_out, int out_size, void* d_ws, size_t ws_size, hipStream_t stream) {
    static int grid = 0;
    if (grid == 0) {
        if (n_in != 23 || out_size != MTOK * DM || ws_size < WS_END) { fprintf(stderr, "kernel_launch: unexpected shapes (n_in %d out %d ws %zu)\n", n_in, out_size, ws_size); grid = -1; return; }
        int dev = 0, cus = 0, per_cu = 0;
        hipGetDevice(&dev); hipDeviceGetAttribute(&cus, hipDeviceAttributeMultiprocessorCount, dev);
        if (hipFuncSetAttribute((const void*)fwd_megakernel, hipFuncAttributeMaxDynamicSharedMemorySize, LDS_BYTES) != hipSuccess) { fprintf(stderr, "kernel_launch: hipFuncSetAttribute failed\n"); grid = -1; return; }
        if (hipOccupancyMaxActiveBlocksPerMultiprocessor(&per_cu, (const void*)fwd_megakernel, NWAVES * 64, LDS_BYTES) != hipSuccess || per_cu < 1) { fprintf(stderr, "kernel_launch: occupancy query says %d\n", per_cu); per_cu = 1; }
        (void)hipGetLastError();
        grid = cus * 1;
    }
    if (grid < 0) return;
    if (hipMemsetAsync((char*)d_ws + WS_BAR, 0, BAR_BYTES, stream) != hipSuccess) { fprintf(stderr, "kernel_launch: memset of the barrier words failed\n"); return; }
    Params p{};
    for (int i = 0; i < 23; ++i) p.in[i] = (const float*)d_in[i];
    p.out = (float*)d_out; p.ws = (unsigned char*)d_ws;
    void* args[] = {&p};
    hipError_t e = hipLaunchCooperativeKernel((const void*)fwd_megakernel, dim3(grid), dim3(NWAVES * 64), args, LDS_BYTES, stream);
    if (e != hipSuccess) fprintf(stderr, "cooperative launch failed: %s (grid %d)\n", hipGetErrorString(e), grid);
}
```
